# Optimizing an MI355X kernel written in HIP

```python
import math
import jax, jax.numpy as jnp
from jax import lax
import numpy as np

D_MODEL = 1024
BATCH = 16
SEQ = 2048
DEPTH = 1

HEAD_DIM = 64
ROPE_THETA = 10000.0
EPS = 1e-6
NEG_INF = -1e30
DSW_WINDOWS = (128, 512, 2048)
DSW_DILATIONS = (1, 4, 16)
DSW_GROUPS = 3
DSW_HEADS_PER_GROUP = D_MODEL // 128
DSW_HEADS = DSW_GROUPS * DSW_HEADS_PER_GROUP
DSW_QKV_WIDTH = DSW_HEADS * HEAD_DIM
DSW_OUT_WIDTH = DSW_HEADS_PER_GROUP * HEAD_DIM
DIFF_HEADS = D_MODEL // (2 * HEAD_DIM)
DIFF_QK_WIDTH = DIFF_HEADS * 2 * HEAD_DIM
DIFF_V_WIDTH = DIFF_HEADS * 2 * HEAD_DIM
Q_BLOCK = 128
IN_WIDTHS = (DSW_QKV_WIDTH, DSW_QKV_WIDTH, DSW_QKV_WIDTH, DSW_OUT_WIDTH,
             DIFF_QK_WIDTH, DIFF_QK_WIDTH, DIFF_V_WIDTH, DIFF_V_WIDTH,
             2 * D_MODEL)
IN_WIDTH = sum(IN_WIDTHS)

kernel_name = "hybrid_dilated_diff_attention_block"


def rms_norm(x, w):
    xf = x.astype(jnp.float32)
    y = xf * lax.rsqrt(jnp.mean(xf * xf, axis=-1, keepdims=True) + EPS)
    return (y * w.astype(jnp.float32)).astype(x.dtype)


def rope(x, positions):
    B, S = positions.shape
    half = x.shape[-1] // 2
    inv_freq = ROPE_THETA ** (-jnp.arange(half, dtype=jnp.float32) / half)
    ang = positions.astype(jnp.float32)[..., None] * inv_freq
    ang = ang.reshape((B, S) + (1,) * (x.ndim - 3) + (half,))
    cos, sin = jnp.cos(ang), jnp.sin(ang)
    xf = x.astype(jnp.float32)
    x1, x2 = xf[..., :half], xf[..., half:]
    out = jnp.concatenate([x1 * cos - x2 * sin, x2 * cos + x1 * sin], axis=-1)
    return out.astype(x.dtype)


def dilated_window_attention(q, k, v, window, dilation):
    B, S, H, Dh = q.shape
    r = window // (2 * dilation)
    L = S // dilation
    nb = -(-L // r)
    Lp = nb * r

    def to_blocks(t):
        t = t.reshape(B, L, dilation, H, Dh)
        t = jnp.pad(t, ((0, 0), (0, Lp - L), (0, 0), (0, 0), (0, 0)))
        return t.reshape(B, nb, r, dilation, H, Dh)

    def band(t):
        tp = jnp.pad(t, ((0, 0), (1, 1), (0, 0), (0, 0), (0, 0), (0, 0)))
        return jnp.concatenate([tp[:, :-2], tp[:, 1:-1], tp[:, 2:]], axis=2)

    qb = to_blocks(q)
    kw = band(to_blocks(k))
    vw = band(to_blocks(v))
    s = jnp.einsum('bnishe,bnjshe->bnshij', qb, kw).astype(jnp.float32) * (Dh ** -0.5)
    i = jnp.arange(r)[:, None]
    j = jnp.arange(3 * r)[None, :]
    lk = jnp.arange(nb)[:, None, None] * r + j[None] - r
    valid = (jnp.abs(j - r - i) <= r)[None] & (lk >= 0) & (lk < L)
    s = jnp.where(valid[None, :, None, None], s, NEG_INF)
    m = jnp.max(s, axis=-1, keepdims=True)
    p = jnp.exp(s - m)
    den = jnp.sum(p, axis=-1, keepdims=True)
    o = jnp.einsum('bnshij,bnjshe->bnishe', (p / den).astype(v.dtype), vw)
    lse = (m + jnp.log(den))[..., 0]
    o = o.reshape(B, Lp, dilation, H, Dh)[:, :L].reshape(B, S, H, Dh)
    lse = jnp.transpose(lse, (0, 1, 4, 2, 3)).reshape(B, Lp, dilation, H)[:, :L].reshape(B, S, H)
    return o, lse


def differential_attention(q, k, v, lam):
    B, S, H, _, Dh = q.shape
    nq = S // Q_BLOCK
    qblocks = jnp.moveaxis(q.reshape(B, nq, Q_BLOCK, H, 2, Dh), 1, 0)

    def one_block(qblk):
        s = jnp.einsum('bihce,bjhce->bhcij', qblk, k).astype(jnp.float32) * (Dh ** -0.5)
        p = jax.nn.softmax(s, axis=-1)
        a = p[:, :, 0] - lam * p[:, :, 1]
        return jnp.einsum('bhij,bjhe->bihe', a.astype(v.dtype), v)

    o = lax.map(one_block, qblocks)
    return jnp.moveaxis(o, 0, 1).reshape(B, S, H, 2 * Dh)


def hybrid_layer(x, c, positions, w_ada, b_ada, norm_pre, w_in, lambda_q1, lambda_k1,
                 lambda_q2, lambda_k2, diff_subln, w_proj_a, w_proj_b, w_out, norm_post,
                 lambda_init):
    B, S, D = x.shape
    mod = jax.nn.silu(c) @ w_ada + b_ada
    shift, scale, gate = jnp.split(mod, 3, axis=-1)
    h = rms_norm(x, norm_pre) * (1.0 + scale[:, None]) + shift[:, None]
    proj = h @ w_in
    points, acc = [], 0
    for wdt in IN_WIDTHS[:-1]:
        acc += wdt
        points.append(acc)
    qa, ka, va, za, qd, kd, vd, zd, gm = jnp.split(proj, points, axis=-1)

    qa = rope(qa.reshape(B, S, DSW_HEADS, HEAD_DIM), positions)
    ka = rope(ka.reshape(B, S, DSW_HEADS, HEAD_DIM), positions)
    va = va.reshape(B, S, DSW_HEADS, HEAD_DIM)
    outs, lses = [], []
    for g, (win, dil) in enumerate(zip(DSW_WINDOWS, DSW_DILATIONS)):
        sl = slice(g * DSW_HEADS_PER_GROUP, (g + 1) * DSW_HEADS_PER_GROUP)
        o_g, lse_g = dilated_window_attention(qa[:, :, sl], ka[:, :, sl], va[:, :, sl], win, dil)
        outs.append(o_g)
        lses.append(lse_g)
    alpha = jax.nn.softmax(jnp.stack(lses), axis=0)
    ya = jnp.sum(alpha[..., None] * jnp.stack(outs).astype(jnp.float32), axis=0)
    ya = ya.astype(x.dtype).reshape(B, S, DSW_OUT_WIDTH) * jax.nn.silu(za)
    pa = ya @ w_proj_a

    qd = rope(qd.reshape(B, S, DIFF_HEADS, 2, HEAD_DIM), positions)
    kd = rope(kd.reshape(B, S, DIFF_HEADS, 2, HEAD_DIM), positions)
    vd = vd.reshape(B, S, DIFF_HEADS, 2 * HEAD_DIM)
    f32 = jnp.float32
    lam = (jnp.exp(jnp.sum(lambda_q1.astype(f32) * lambda_k1.astype(f32)))
           - jnp.exp(jnp.sum(lambda_q2.astype(f32) * lambda_k2.astype(f32))) + lambda_init)
    yd = differential_attention(qd, kd, vd, lam)
    yd = rms_norm(yd, diff_subln) * (1.0 - lambda_init)
    yd = yd.reshape(B, S, DIFF_V_WIDTH) * jax.nn.silu(zd)
    pb = yd @ w_proj_b

    ga, gb = jnp.split(jax.nn.sigmoid(gm), 2, axis=-1)
    y = (ga * pa + gb * pb) @ w_out
    y = rms_norm(y, norm_post)
    return x + gate[:, None] * y


def setup_inputs(seed: int = 0) -> dict:
    key = jax.random.key(seed)
    ks = jax.random.split(key, 20)
    D = D_MODEL
    nrm = jax.random.normal
    x = nrm(ks[0], (BATCH, SEQ, D), jnp.float32)
    c = nrm(ks[1], (BATCH, D), jnp.float32)
    positions = (jnp.arange(SEQ, dtype=jnp.int32)[None, :]
                 + jax.random.randint(ks[2], (BATCH, 1), 0, 1024, dtype=jnp.int32))
    w_ada = nrm(ks[3], (DEPTH, D, 3 * D), jnp.float32) * (0.5 * D ** -0.5)
    b_ada = nrm(ks[4], (DEPTH, 3 * D), jnp.float32) * 0.02
    norm_pre = 1.0 + 0.01 * nrm(ks[5], (DEPTH, D), jnp.float32)
    w_in = nrm(ks[6], (DEPTH, D, IN_WIDTH), jnp.float32) * D ** -0.5
    lambda_q1 = nrm(ks[7], (DEPTH, HEAD_DIM), jnp.float32) * 0.1
    lambda_k1 = nrm(ks[8], (DEPTH, HEAD_DIM), jnp.float32) * 0.1
    lambda_q2 = nrm(ks[9], (DEPTH, HEAD_DIM), jnp.float32) * 0.1
    lambda_k2 = nrm(ks[10], (DEPTH, HEAD_DIM), jnp.float32) * 0.1
    diff_subln = 1.0 + 0.01 * nrm(ks[11], (DEPTH, 2 * HEAD_DIM), jnp.float32)
    w_proj_a = nrm(ks[12], (DEPTH, DSW_OUT_WIDTH, D), jnp.float32) * DSW_OUT_WIDTH ** -0.5
    w_proj_b = nrm(ks[13], (DEPTH, DIFF_V_WIDTH, D), jnp.float32) * DIFF_V_WIDTH ** -0.5
    w_out = nrm(ks[14], (DEPTH, D, D), jnp.float32) * D ** -0.5
    norm_post = 1.0 + 0.01 * nrm(ks[15], (DEPTH, D), jnp.float32)
    return {"x": x, "c": c, "positions": positions, "w_ada": w_ada, "b_ada": b_ada,
            "norm_pre": norm_pre, "w_in": w_in, "lambda_q1": lambda_q1, "lambda_k1": lambda_k1,
            "lambda_q2": lambda_q2, "lambda_k2": lambda_k2, "diff_subln": diff_subln,
            "w_proj_a": w_proj_a, "w_proj_b": w_proj_b, "w_out": w_out, "norm_post": norm_post}


def reference(x, c, positions, w_ada, b_ada, norm_pre, w_in, lambda_q1, lambda_k1,
              lambda_q2, lambda_k2, diff_subln, w_proj_a, w_proj_b, w_out, norm_post):
    for l in range(DEPTH):
        lambda_init = 0.8 - 0.6 * math.exp(-0.3 * l)
        x = hybrid_layer(x, c, positions, w_ada[l], b_ada[l], norm_pre[l], w_in[l],
                         lambda_q1[l], lambda_k1[l], lambda_q2[l], lambda_k2[l], diff_subln[l],
                         w_proj_a[l], w_proj_b[l], w_out[l], norm_post[l], lambda_init)
    return x
```

```cpp
#include <hip/hip_runtime.h>
#include <hip/hip_cooperative_groups.h>
#include <cstdio>
#include <cstdint>
namespace cg = cooperative_groups;

constexpr int DM = 1024, NBATCH = 16, SEQ = 2048, MTOT = NBATCH * SEQ;
constexpr int NCHUNK = 2, MC = MTOT / NCHUNK, BPC = NBATCH / NCHUNK;
constexpr int NIN = 11264;
constexpr int C_QA = 0, C_KA = 1536, C_VA = 3072, C_ZA = 4608, C_QD = 5120, C_KD = 6144, C_VD = 7168, C_ZD = 8192, C_GA = 9216, C_GB = 10240;
constexpr int C_U = 0, C_Y = 1536;
constexpr int KCAT = 1536;
constexpr float QSCALE = 0.125f * 1.4426950408889634f;
constexpr float EPS = 1e-6f;
constexpr size_t MiB = 1u << 20;
constexpr size_t WS_MODP = 0;
constexpr size_t WS_LAM = 800 * 1024;
constexpr size_t WS_ROWSS = 832 * 1024;
constexpr size_t WS_TAB = 1 * MiB;
constexpr size_t WS_WIN = 9 * MiB;
constexpr size_t WS_WCAT = 31 * MiB;
constexpr size_t WS_WOUT = 34 * MiB;
constexpr size_t WS_LSE = 36 * MiB;
constexpr size_t WS_H = 38 * MiB;
constexpr size_t WS_ACAT = 102 * MiB;
constexpr size_t WS_PROJ = 150 * MiB;
constexpr size_t WS_END = 502 * MiB;
constexpr int LDS_BYTES = 147456;
constexpr int NWAVES = 8;

#define LAS __attribute__((address_space(3)))
typedef unsigned short bf16_t;
typedef short bf16x8 __attribute__((ext_vector_type(8)));
typedef short s16x4 __attribute__((ext_vector_type(4)));
typedef float f32x4 __attribute__((ext_vector_type(4)));
typedef float f32x2 __attribute__((ext_vector_type(2)));
typedef float f32x16 __attribute__((ext_vector_type(16)));
typedef unsigned u32x4 __attribute__((ext_vector_type(4)));
typedef unsigned u32x2 __attribute__((ext_vector_type(2)));
typedef __bf16 bf16x2_t __attribute__((ext_vector_type(2)));
__device__ __forceinline__ unsigned cvtpk(float lo, float hi) { f32x2 v = {lo, hi}; bf16x2_t b = __builtin_convertvector(v, bf16x2_t); return __builtin_bit_cast(unsigned, b); }
__device__ __forceinline__ float bflo(unsigned w) { return __uint_as_float(w << 16); }
__device__ __forceinline__ float bfhi(unsigned w) { return __uint_as_float(w & 0xffff0000u); }
__device__ __forceinline__ float fexp2(float x) { return __builtin_amdgcn_exp2f(x); }
__device__ __forceinline__ float frcp(float x) { return __builtin_amdgcn_rcpf(x); }
__device__ __forceinline__ float sigmoidf_(float v) { return frcp(1.0f + fexp2(-1.4426950408889634f * v)); }
__device__ __forceinline__ float siluf_(float v) { return v * sigmoidf_(v); }

namespace pg8 {
#define PG8_LAS __attribute__((address_space(3)))
constexpr int BM = 256, BK = 64, HALF = 128, HTB = HALF * BK * 2  , STAGE_BYTES = 8 * HTB, NXCD = 8, WGM = 8;

__host__ __device__ __forceinline__ int lds_byte(int r, int c) { const int st = (r >> 4) * 2 + (c >> 5), rr = r & 15, cc = c & 31, ob = rr * 64 + cc * 2; return st * 1024 + (ob ^ (((ob >> 9) & 1) << 5)); }
__host__ __device__ __forceinline__ void stage_rc(int b, int& R, int& C) { const int st = b / 1024, sb = b % 1024, swz = sb ^ (((sb >> 9) & 1) << 5); R = (st >> 1) * 16 + swz / 64; C = (st & 1) * 32 + (swz % 64) / 2; }
__host__ __device__ __forceinline__ int perm32(int rho) { const int n = rho >> 4, i = rho & 15; return 8 * (i >> 2) + 4 * n + (i & 3); }

struct Unit { int pm, pn; };
template <int M_, int N_, int K_, int LDA_, int LDB_> struct Gemm { const bf16_t* A; const bf16_t* Bt; static constexpr int M = M_, N = N_, K = K_, lda = LDA_, ldb = LDB_; };

template <int M_, int N_> struct StaticOrder {
    static constexpr int nM = M_ / BM, nN = N_ / BM, nwg = nM * nN;
    int G, c;
    __host__ __device__ void init(int G_, int c_) { G = G_; c = c_; }
    __host__ __device__ bool next(int i, Unit& u) const {
        const int L = i * G + c; if (L >= nwg) return false;
        int wgid = L; { constexpr int q = nwg / NXCD, r = nwg % NXCD; const int xcd = wgid % NXCD, off = wgid / NXCD; wgid = (xcd < r ? xcd * (q + 1) : r * (q + 1) + (xcd - r) * q) + off; }
        constexpr int nig = WGM * nN; const int gid = wgid / nig, fm = gid * WGM, gsz = (nM - fm) < WGM ? (nM - fm) : WGM;
        u.pm = fm + ((wgid % nig) % gsz); u.pn = (wgid % nig) / gsz; return true;
    }
    __device__ __forceinline__ void a_ready(const Unit&) const {}
    __device__ __forceinline__ void done(const Unit&) const {}
};


template <class Epi, class Sched, class GemmT, bool ALIGN_EPI = false, bool SP2 = false>
__device__ __forceinline__ void gemm_phase(PG8_LAS unsigned char* lds, const GemmT g, const Sched& S, const Epi& E) {
    int tid_ = threadIdx.x; asm volatile("" : "+v"(tid_));
    const int tid = tid_, wid = __builtin_amdgcn_readfirstlane(tid >> 6), lane = tid & 63, wr = wid >> 2, wc = wid & 3, fr = lane & 15, fq = lane >> 4;
    constexpr int K = GemmT::K, nt = K / BK;
    unsigned voffA[2], voffB[2];
#pragma unroll
    for (int i = 0; i < 2; ++i) { int R, C; stage_rc(tid * 16 + i * 8192, R, C); const int Rb = Epi::PERM ? ((R & ~31) + perm32(R & 31)) : R;
        voffA[i] = (unsigned)(R * GemmT::lda + C) * 2u; voffB[i] = (unsigned)(Rb * GemmT::ldb + C) * 2u; }
    constexpr size_t kstep = (size_t)(BK * 2);
    constexpr size_t hstepA = (size_t)HALF * GemmT::lda * 2, hstepB = (size_t)HALF * GemmT::ldb * 2;
    constexpr size_t tstepA = 2 * hstepA, tstepB = 2 * hstepB;
    const unsigned ldsw = (unsigned)wid * 1024u;
    const int aoff = lds_byte(wr * 64 + fr, fq * 8), boff = lds_byte(wc * 32 + fr, fq * 8);
#define PG8_SA(b, h) (((b) * 2 + (h)) * HTB)
#define PG8_SB(b, h) ((4 + (b) * 2 + (h)) * HTB)
#define PG8_STAGE(bufoff, gbase, voff) do { _Pragma("unroll") for (int _i = 0; _i < 2; ++_i) \
        __builtin_amdgcn_global_load_lds((const unsigned*)((const char*)(gbase) + (voff)[_i]), (PG8_LAS unsigned*)(lds + (bufoff) + ldsw + _i * 8192), 16, 0, 0); } while (0)
#define PG8_LDA(dst, b, h) do { _Pragma("unroll") for (int m = 0; m < 4; ++m) _Pragma("unroll") for (int k = 0; k < 2; ++k) dst[m][k] = *(const PG8_LAS bf16x8*)(lds + PG8_SA(b, h) + aoff + m * 2048 + k * 1024); } while (0)
#define PG8_LDB(dst, b, h) do { _Pragma("unroll") for (int n = 0; n < 2; ++n) _Pragma("unroll") for (int k = 0; k < 2; ++k) dst[n][k] = *(const PG8_LAS bf16x8*)(lds + PG8_SB(b, h) + boff + n * 2048 + k * 1024); } while (0)
#define PG8_MMA(ai, bj, At, Bt) do { __builtin_amdgcn_s_setprio(1); _Pragma("unroll") for (int m = 0; m < 4; ++m) _Pragma("unroll") for (int n = 0; n < 2; ++n) _Pragma("unroll") for (int k = 0; k < 2; ++k) \
        acc[ai][bj][m][n] = __builtin_amdgcn_mfma_f32_16x16x32_bf16(Bt[n][k], At[m][k], acc[ai][bj][m][n], 0, 0, 0); __builtin_amdgcn_s_setprio(0); } while (0)
#define PG8_WAIT_V(n) asm volatile("s_waitcnt vmcnt(" #n ")" ::: "memory")
#define PG8_WAIT_L(n) asm volatile("s_waitcnt lgkmcnt(" #n ")" ::: "memory")
#define PG8_BAR __builtin_amdgcn_s_barrier()
#define PG8_SCHED __builtin_amdgcn_sched_barrier(0)
    Unit cur, nxt; int ui = 0;
    if (!S.next(0, cur)) return;
    f32x4 acc[2][2][4][2];
#pragma unroll
    for (int a = 0; a < 2; ++a)
#pragma unroll
        for (int b = 0; b < 2; ++b)
#pragma unroll
            for (int m = 0; m < 4; ++m)
#pragma unroll
                for (int n = 0; n < 2; ++n) acc[a][b][m][n] = (f32x4){0.f, 0.f, 0.f, 0.f};
    bf16x8 At[4][2], B0[2][2], B1[2][2];
    const char* cA = (const char*)g.A + (size_t)cur.pm * tstepA; const char* cB = (const char*)g.Bt + (size_t)cur.pn * tstepB;
    S.a_ready(cur);
    if constexpr (SP2) {
        PG8_STAGE(PG8_SB(0, 0), cB, voffB); PG8_STAGE(PG8_SB(0, 1), cB + hstepB, voffB); PG8_STAGE(PG8_SA(0, 0), cA, voffA); PG8_STAGE(PG8_SA(0, 1), cA + hstepA, voffA);
        if (wr == 1) PG8_BAR;
        PG8_WAIT_V(2); PG8_BAR;
        PG8_STAGE(PG8_SB(1, 0), cB + kstep, voffB); PG8_STAGE(PG8_SA(1, 0), cA + kstep, voffA); PG8_STAGE(PG8_SB(1, 1), cB + hstepB + kstep, voffB);
        PG8_WAIT_V(6); PG8_BAR;
    } else {
        PG8_STAGE(PG8_SB(0, 0), cB, voffB); PG8_STAGE(PG8_SA(0, 0), cA, voffA); PG8_STAGE(PG8_SB(0, 1), cB + hstepB, voffB); PG8_STAGE(PG8_SA(0, 1), cA + hstepA, voffA);
        if (wr == 1) PG8_BAR;
        PG8_WAIT_V(4); PG8_BAR;
        PG8_STAGE(PG8_SB(1, 0), cB + kstep, voffB); PG8_STAGE(PG8_SA(1, 0), cA + kstep, voffA); PG8_STAGE(PG8_SB(1, 1), cB + hstepB + kstep, voffB);
        PG8_WAIT_V(6); PG8_BAR;
    }
    for (;;) {
        const bool has_next = S.next(ui + 1, nxt);
        const char* nA = has_next ? (const char*)g.A + (size_t)nxt.pm * tstepA : cA; const char* nB = has_next ? (const char*)g.Bt + (size_t)nxt.pn * tstepB : cB;
        constexpr int NSEG = (Epi::MID_T > 0) ? 2 : 1;
#pragma unroll 1
        for (int seg = 0; seg < NSEG; ++seg) {
        const int t_beg = (seg == 0) ? 0 : Epi::MID_T, t_end = (NSEG == 2 && seg == 0) ? Epi::MID_T : nt;
#pragma unroll 1
        for (int t = t_beg; t < t_end; t += 2) {
            const bool last = (t == nt - 2);
            const char* a1 = cA + (size_t)(t + 1) * kstep;
            const char* a2 = last ? nA : cA + (size_t)(t + 2) * kstep; const char* b2 = last ? nB : cB + (size_t)(t + 2) * kstep;
            const char* a3 = a2 + kstep; const char* b3 = b2 + kstep;
            if (last && has_next) S.a_ready(nxt);
            if constexpr (SP2) {
            PG8_LDB(B0, 0, 0); PG8_LDB(B1, 0, 1); PG8_SCHED; PG8_LDA(At, 0, 0); PG8_STAGE(PG8_SA(1, 1), a1 + hstepA, voffA);
            PG8_WAIT_V(8); PG8_WAIT_L(0); PG8_BAR; PG8_MMA(0, 0, At, B0); PG8_MMA(0, 1, At, B1); PG8_BAR; PG8_SCHED;
            PG8_LDA(At, 0, 1); PG8_STAGE(PG8_SB(0, 0), b2, voffB); PG8_STAGE(PG8_SB(0, 1), b2 + hstepB, voffB); PG8_STAGE(PG8_SA(0, 0), a2, voffA);
            PG8_WAIT_V(8); PG8_WAIT_L(0); PG8_BAR; PG8_MMA(1, 0, At, B0); PG8_MMA(1, 1, At, B1); PG8_BAR; PG8_SCHED;
            PG8_LDB(B0, 1, 0); PG8_LDB(B1, 1, 1); PG8_SCHED; PG8_LDA(At, 1, 0); PG8_STAGE(PG8_SA(0, 1), a2 + hstepA, voffA);
            PG8_WAIT_V(8); PG8_WAIT_L(0); PG8_BAR; PG8_MMA(0, 0, At, B0); PG8_MMA(0, 1, At, B1); PG8_BAR; PG8_SCHED;
            PG8_LDA(At, 1, 1); PG8_STAGE(PG8_SB(1, 0), b3, voffB); PG8_STAGE(PG8_SB(1, 1), b3 + hstepB, voffB); PG8_STAGE(PG8_SA(1, 0), a3, voffA);
            PG8_WAIT_V(8); PG8_WAIT_L(0); PG8_BAR; PG8_MMA(1, 0, At, B0); PG8_MMA(1, 1, At, B1); PG8_BAR; PG8_SCHED;
            } else {
            PG8_LDB(B0, 0, 0); PG8_SCHED; PG8_LDA(At, 0, 0); PG8_STAGE(PG8_SA(1, 1), a1 + hstepA, voffA);
            PG8_WAIT_L(8); PG8_BAR; PG8_WAIT_L(0); PG8_MMA(0, 0, At, B0); PG8_BAR; PG8_SCHED;
            PG8_LDB(B1, 0, 1); PG8_STAGE(PG8_SB(0, 0), b2, voffB);
            PG8_BAR; PG8_WAIT_L(0); PG8_MMA(0, 1, At, B1); PG8_BAR;
            PG8_LDA(At, 0, 1); PG8_STAGE(PG8_SA(0, 0), a2, voffA);
            PG8_BAR; PG8_WAIT_L(0); PG8_MMA(1, 0, At, B0); PG8_BAR; PG8_SCHED;
            PG8_STAGE(PG8_SB(0, 1), b2 + hstepB, voffB);
            PG8_WAIT_V(6); PG8_BAR; PG8_MMA(1, 1, At, B1); PG8_BAR;
            PG8_LDB(B0, 1, 0); PG8_SCHED; PG8_LDA(At, 1, 0); PG8_STAGE(PG8_SA(0, 1), a2 + hstepA, voffA);
            PG8_WAIT_L(8); PG8_BAR; PG8_WAIT_L(0); PG8_MMA(0, 0, At, B0); PG8_BAR; PG8_SCHED;
            PG8_LDB(B1, 1, 1); PG8_STAGE(PG8_SB(1, 0), b3, voffB);
            PG8_BAR; PG8_WAIT_L(0); PG8_MMA(0, 1, At, B1); PG8_BAR;
            PG8_LDA(At, 1, 1); PG8_STAGE(PG8_SA(1, 0), a3, voffA);
            PG8_BAR; PG8_WAIT_L(0); PG8_MMA(1, 0, At, B0); PG8_BAR; PG8_SCHED;
            PG8_STAGE(PG8_SB(1, 1), b3 + hstepB, voffB);
            PG8_WAIT_V(6); PG8_BAR; PG8_MMA(1, 1, At, B1); PG8_BAR;
            }
        }
        if constexpr (NSEG == 2) { if (seg == 0) E.mid(acc, cur, wr, wc, fr, fq); }
        }
        if constexpr (ALIGN_EPI) { if (wr == 0) PG8_BAR; }
        if constexpr (!Epi::AFTER_DRAIN) { E(acc, cur, wr, wc, fr, fq); S.done(cur); }
        if (!has_next) break;
#pragma unroll
        for (int a = 0; a < 2; ++a)
#pragma unroll
            for (int b = 0; b < 2; ++b)
#pragma unroll
                for (int m = 0; m < 4; ++m)
#pragma unroll
                    for (int n = 0; n < 2; ++n) acc[a][b][m][n] = (f32x4){0.f, 0.f, 0.f, 0.f};
        cur = nxt; cA = nA; cB = nB; ++ui;
        if constexpr (ALIGN_EPI) { if (wr == 1) PG8_BAR; }
    }
    PG8_WAIT_V(0);
    if constexpr (!ALIGN_EPI) { if (wr == 0) PG8_BAR; }
    PG8_BAR;
    if constexpr (Epi::AFTER_DRAIN) { E.fused(acc, cur, wr, wc, fr, fq, lds, wid, lane); S.done(cur); }
#undef PG8_SA
#undef PG8_SB
#undef PG8_STAGE
#undef PG8_LDA
#undef PG8_LDB
#undef PG8_MMA
#undef PG8_WAIT_V
#undef PG8_WAIT_L
#undef PG8_BAR
#undef PG8_SCHED
}
}

namespace pg8 {
struct EpiIn {
    static constexpr bool PERM = true, AFTER_DRAIN = false; static constexpr int MID_T = 0;
    bf16_t* P; const float* tab;
    __device__ __forceinline__ void operator()(const f32x4 (&acc)[2][2][4][2], const Unit& u, int wr, int wc, int fr, int fq) const {
        const int pn = u.pn;
        int mode;
        if (pn < 6) mode = 1; else if (pn < 12) mode = 2; else if (pn < 18) mode = 0; else if (pn < 20) mode = 3; else if (pn < 24) mode = 1;
        else if (pn < 28) mode = 2; else if (pn < 32) mode = 0; else if (pn < 36) mode = 3; else mode = 4;
        int row0 = u.pm * BM + wr * 64 + fr, col0 = pn * BM + wc * 32 + 8 * fq;
        asm volatile("" : "+v"(row0), "+v"(col0));
#pragma unroll
        for (int ai = 0; ai < 2; ++ai)
#pragma unroll
            for (int m = 0; m < 4; ++m) {
                const int row = row0 + ai * HALF + m * 16;
                bf16_t* rowp = P + (size_t)row * NIN + col0;
#pragma unroll
                for (int bj = 0; bj < 2; ++bj) {
                    f32x4 v0 = acc[ai][bj][m][0], v1 = acc[ai][bj][m][1];
                    if (mode == 1 || mode == 2) {
                        const int f0 = ((col0 + bj * HALF) & 63) >> 1;
                        const float* tp = tab + ((size_t)row * 32 + f0) * 2;
                        const f32x4 c0 = *(const f32x4*)tp, c1 = *(const f32x4*)(tp + 4);
                        const float sc = (mode == 1) ? QSCALE : 1.0f;
                        f32x4 o0, o1;
                        o0[0] = (v0[0] * c0[0] - v0[1] * c0[1]) * sc; o0[1] = (v0[1] * c0[0] + v0[0] * c0[1]) * sc;
                        o0[2] = (v0[2] * c0[2] - v0[3] * c0[3]) * sc; o0[3] = (v0[3] * c0[2] + v0[2] * c0[3]) * sc;
                        o1[0] = (v1[0] * c1[0] - v1[1] * c1[1]) * sc; o1[1] = (v1[1] * c1[0] + v1[0] * c1[1]) * sc;
                        o1[2] = (v1[2] * c1[2] - v1[3] * c1[3]) * sc; o1[3] = (v1[3] * c1[2] + v1[2] * c1[3]) * sc;
                        v0 = o0; v1 = o1;
                    } else if (mode == 3) {
#pragma unroll
                        for (int e = 0; e < 4; ++e) { v0[e] = siluf_(v0[e]); v1[e] = siluf_(v1[e]); }
                    } else if (mode == 4) {
#pragma unroll
                        for (int e = 0; e < 4; ++e) { v0[e] = sigmoidf_(v0[e]); v1[e] = sigmoidf_(v1[e]); }
                    }
                    u32x4 w; w.x = cvtpk(v0[0], v0[1]); w.y = cvtpk(v0[2], v0[3]); w.z = cvtpk(v1[0], v1[1]); w.w = cvtpk(v1[2], v1[3]);
                    *(u32x4*)(rowp + bj * HALF) = w;
                }
            }
    }
};
struct EpiU {
    static constexpr bool PERM = true, AFTER_DRAIN = false; static constexpr int MID_T = 8;
    bf16_t* P;
    __device__ __forceinline__ void mid(f32x4 (&acc)[2][2][4][2], const Unit& u, int wr, int wc, int fr, int fq) const {
        int row0 = u.pm * BM + wr * 64 + fr, col0 = u.pn * BM + wc * 32 + 8 * fq;
        asm volatile("" : "+v"(row0), "+v"(col0));
#pragma unroll
        for (int ai = 0; ai < 2; ++ai)
#pragma unroll
            for (int m = 0; m < 4; ++m) {
                const bf16_t* rowp = P + (size_t)(row0 + ai * HALF + m * 16) * NIN + col0;
#pragma unroll
                for (int bj = 0; bj < 2; ++bj) {
                    const u32x4 a = *(const u32x4*)(rowp + C_GA + bj * HALF), b = *(const u32x4*)(rowp + C_GB + bj * HALF);
                    f32x4 r0, r1;
                    r0[0] = bflo(a.x) * frcp(bflo(b.x)); r0[1] = bfhi(a.x) * frcp(bfhi(b.x)); r0[2] = bflo(a.y) * frcp(bflo(b.y)); r0[3] = bfhi(a.y) * frcp(bfhi(b.y));
                    r1[0] = bflo(a.z) * frcp(bflo(b.z)); r1[1] = bfhi(a.z) * frcp(bfhi(b.z)); r1[2] = bflo(a.w) * frcp(bflo(b.w)); r1[3] = bfhi(a.w) * frcp(bfhi(b.w));
                    acc[ai][bj][m][0] *= r0; acc[ai][bj][m][1] *= r1;
                    asm volatile("" ::: "memory");
                }
            }
    }
    __device__ __forceinline__ void operator()(const f32x4 (&acc)[2][2][4][2], const Unit& u, int wr, int wc, int fr, int fq) const {
        int row0 = u.pm * BM + wr * 64 + fr, col0 = u.pn * BM + wc * 32 + 8 * fq;
        asm volatile("" : "+v"(row0), "+v"(col0));
#pragma unroll
        for (int ai = 0; ai < 2; ++ai)
#pragma unroll
            for (int m = 0; m < 4; ++m) {
                bf16_t* rowp = P + (size_t)(row0 + ai * HALF + m * 16) * NIN + col0;
#pragma unroll
                for (int bj = 0; bj < 2; ++bj) {
                    const u32x4 b = *(const u32x4*)(rowp + C_GB + bj * HALF);
                    const f32x4 v0 = acc[ai][bj][m][0], v1 = acc[ai][bj][m][1];
                    u32x4 w; w.x = cvtpk(v0[0] * bflo(b.x), v0[1] * bfhi(b.x)); w.y = cvtpk(v0[2] * bflo(b.y), v0[3] * bfhi(b.y));
                    w.z = cvtpk(v1[0] * bflo(b.z), v1[1] * bfhi(b.z)); w.w = cvtpk(v1[2] * bflo(b.w), v1[3] * bfhi(b.w));
                    *(u32x4*)(rowp + C_U + bj * HALF) = w;
                }
                asm volatile("" ::: "memory");
            }
    }
};
struct EpiY {
    static constexpr bool PERM = true, AFTER_DRAIN = false; static constexpr int MID_T = 0;
    bf16_t* P; float* rowss;
    __device__ __forceinline__ void operator()(const f32x4 (&acc)[2][2][4][2], const Unit& u, int wr, int wc, int fr, int fq) const {
        int row0 = u.pm * BM + wr * 64 + fr, col0 = u.pn * BM + wc * 32 + 8 * fq;
        asm volatile("" : "+v"(row0), "+v"(col0));
#pragma unroll
        for (int ai = 0; ai < 2; ++ai)
#pragma unroll
            for (int m = 0; m < 4; ++m) {
                const int row = row0 + ai * HALF + m * 16;
                bf16_t* rowp = P + (size_t)row * NIN + C_Y + col0;
                float ss = 0.f;
#pragma unroll
                for (int bj = 0; bj < 2; ++bj) {
                    const f32x4 v0 = acc[ai][bj][m][0], v1 = acc[ai][bj][m][1];
                    ss += (v0[0] * v0[0] + v0[1] * v0[1]) + (v0[2] * v0[2] + v0[3] * v0[3]) + (v1[0] * v1[0] + v1[1] * v1[1]) + (v1[2] * v1[2] + v1[3] * v1[3]);
                    u32x4 w; w.x = cvtpk(v0[0], v0[1]); w.y = cvtpk(v0[2], v0[3]); w.z = cvtpk(v1[0], v1[1]); w.w = cvtpk(v1[2], v1[3]);
                    *(u32x4*)(rowp + bj * HALF) = w;
                }
                ss += __shfl_xor(ss, 16); ss += __shfl_xor(ss, 32);
                if (fq == 0) atomicAdd(rowss + row, ss);
            }
    }
};
}

__device__ __forceinline__ float wave_sum(float v) {
#pragma unroll
    for (int o = 1; o < 64; o <<= 1) v += __shfl_xor(v, o);
    return v;
}
__device__ __forceinline__ int win_dest_row(int n) {
    const bool rope = (n < C_VA) || (n >= C_QD && n < C_VD);
    if (!rope) return n;
    const int j = n & 63;
    return (n - j) + 2 * (j & 31) + (j >> 5);
}
template <bool PERMROWS>
__device__ __forceinline__ void transpose_item(const float* W, int N, bf16_t* WT, int ldk, int koff, LAS float* scr, int item, int lane) {
    const int nblk = N / 32, kb = item / nblk, nb = item % nblk, k0 = 64 * kb, n0 = 32 * nb;
#pragma unroll 8
    for (int i = 0; i < 32; ++i) { const int kk = 2 * i + (lane >> 5); scr[kk * 33 + (lane & 31)] = W[(size_t)(k0 + kk) * N + n0 + (lane & 31)]; }
    asm volatile("s_waitcnt lgkmcnt(0)" ::: "memory");
    const int c = lane & 7;
#pragma unroll
    for (int j = 0; j < 4; ++j) { const int n = (lane >> 3) + 8 * j; const LAS float* s = scr + (8 * c) * 33 + n;
        u32x4 o; o.x = cvtpk(s[0 * 33], s[1 * 33]); o.y = cvtpk(s[2 * 33], s[3 * 33]); o.z = cvtpk(s[4 * 33], s[5 * 33]); o.w = cvtpk(s[6 * 33], s[7 * 33]);
        const int dr = PERMROWS ? win_dest_row(n0 + n) : (n0 + n);
        *(u32x4*)(WT + (size_t)dr * ldk + koff + k0 + 8 * c) = o; }
    asm volatile("s_waitcnt lgkmcnt(0)" ::: "memory");
}
__device__ __forceinline__ void sincos_d(double a, float& s, float& c) {
    const double k = __builtin_rint(a * 0.63661977236758134308);
    const double r = __builtin_fma(-k, 6.123233995736766e-17, __builtin_fma(-k, 1.5707963267948966, a));
    const double r2 = r * r;
    double ps = -1.0 / 6227020800.0; ps = ps * r2 + 1.0 / 39916800.0; ps = ps * r2 - 1.0 / 362880.0; ps = ps * r2 + 1.0 / 5040.0; ps = ps * r2 - 1.0 / 120.0; ps = ps * r2 + 1.0 / 6.0; ps = -ps;
    const double sv = r + r * r2 * ps;
    double pc = 1.0 / 479001600.0; pc = pc * r2 - 1.0 / 3628800.0; pc = pc * r2 + 1.0 / 40320.0; pc = pc * r2 - 1.0 / 720.0; pc = pc * r2 + 1.0 / 24.0; pc = pc * r2 - 0.5;
    const double cv = 1.0 + r2 * pc;
    const int q = ((int)k) & 3;
    const double so = (q == 0) ? sv : (q == 1) ? cv : (q == 2) ? -sv : -cv;
    const double co = (q == 0) ? cv : (q == 1) ? -sv : (q == 2) ? -cv : sv;
    s = (float)so; c = (float)co;
}
struct Args { const void* in[16]; float* out; unsigned char* ws; int ph_lo, ph_hi; };
constexpr int N_PHASES = 2 + 5 * NCHUNK;

__device__ __forceinline__ void p0_prologue(const Args& a, LAS unsigned char* lds, int vcu, int G) {
    int tid_ = threadIdx.x; asm volatile("" : "+v"(tid_)); const int tid = tid_, lane = tid & 63, wave = __builtin_amdgcn_readfirstlane(tid >> 6);
    const float* c = (const float*)a.in[1]; const int* pos = (const int*)a.in[2];
    const float* w_ada = (const float*)a.in[3];
    const float* w_in = (const float*)a.in[6];
    const float* w_pa = (const float*)a.in[12]; const float* w_pb = (const float*)a.in[13]; const float* w_out = (const float*)a.in[14];
    unsigned char* ws = a.ws;
    {
        LAS float* sc = (LAS float*)lds;
        LAS float* red = (LAS float*)(lds + 16384);
        float* modp = (float*)(ws + WS_MODP);
        for (int it = vcu; it < 48 * 4; it += G) {
            const int cg_ = it >> 2, kq = it & 3, col = cg_ * 64 + lane;
            __syncthreads();
            for (int e = tid; e < 256 * 16; e += 512) { const int b = e >> 8, k = e & 255; sc[k * 16 + b] = siluf_(c[b * DM + kq * 256 + k]); }
            __syncthreads();
            float acc[16];
#pragma unroll
            for (int b = 0; b < 16; ++b) acc[b] = 0.f;
            const float* wp = w_ada + (size_t)(kq * 256 + wave * 32) * 3072 + col;
#pragma unroll 8
            for (int k = 0; k < 32; ++k) {
                const float w = wp[(size_t)k * 3072];
                const LAS f32x4* s4 = (const LAS f32x4*)(sc + (wave * 32 + k) * 16);
#pragma unroll
                for (int q = 0; q < 4; ++q) { const f32x4 s = s4[q]; acc[4 * q] += s[0] * w; acc[4 * q + 1] += s[1] * w; acc[4 * q + 2] += s[2] * w; acc[4 * q + 3] += s[3] * w; }
            }
#pragma unroll
            for (int b = 0; b < 16; ++b) red[(wave * 16 + b) * 64 + lane] = acc[b];
            __syncthreads();
            for (int e = tid; e < 16 * 64; e += 512) { const int b = e >> 6, cl = e & 63; float s = 0.f;
#pragma unroll
                for (int w = 0; w < 8; ++w) s += red[(w * 16 + b) * 64 + cl];
                modp[((size_t)kq * 16 + b) * 3072 + cg_ * 64 + cl] = s; }
        }
        __syncthreads();
    }
    const int gw = vcu * NWAVES + wave, NGW = G * NWAVES;
    {
        LAS float* scr = (LAS float*)(lds + wave * 16384);
        constexpr int I_IN = (DM / 64) * (NIN / 32), I_A = (512 / 64) * (DM / 32), I_B = (DM / 64) * (DM / 32), I_O = I_B;
        bf16_t* WinT = (bf16_t*)(ws + WS_WIN); bf16_t* WcatT = (bf16_t*)(ws + WS_WCAT); bf16_t* WoutT = (bf16_t*)(ws + WS_WOUT);
        for (int it = gw; it < I_IN + I_A + I_B + I_O; it += NGW) {
            int r = it;
            if (r < I_IN) { transpose_item<true>(w_in, NIN, WinT, DM, 0, scr, r, lane); continue; } r -= I_IN;
            if (r < I_A) { transpose_item<false>(w_pa, DM, WcatT, KCAT, 0, scr, r, lane); continue; } r -= I_A;
            if (r < I_B) { transpose_item<false>(w_pb, DM, WcatT, KCAT, 512, scr, r, lane); continue; } r -= I_B;
            transpose_item<false>(w_out, DM, WoutT, DM, 0, scr, r, lane);
        }
    }
    {
        float* tab = (float*)(ws + WS_TAB);
        const int gt = vcu * 512 + tid, NGT = G * 512;
        for (int e = gt; e < MTOT * 32; e += NGT) {
            const int tok = e >> 5, f = e & 31;
            const float inv = exp2f(-(float)f * (13.287712379549449f / 32.0f));
            const float ang = (float)pos[tok] * inv;
            float s, cs; sincos_d((double)ang, s, cs);
            *(f32x2*)(tab + (size_t)e * 2) = (f32x2){cs, s};
        }
        float* rowss = (float*)(ws + WS_ROWSS);
        for (int e = gt; e < MTOT; e += NGT) rowss[e] = 0.f;
        if (vcu == 0 && wave == 0) {
            const float* q1 = (const float*)a.in[7]; const float* k1 = (const float*)a.in[8]; const float* q2 = (const float*)a.in[9]; const float* k2 = (const float*)a.in[10];
            const float s1 = wave_sum(q1[lane] * k1[lane]), s2 = wave_sum(q2[lane] * k2[lane]);
            if (lane == 0) *(float*)(ws + WS_LAM) = expf(s1) - expf(s2) + 0.2f;
        }
    }
}

__device__ __forceinline__ float mod_at(const float* modp, const float* b_ada, int b, int n) {
    float s = b_ada[n];
#pragma unroll
    for (int kq = 0; kq < 4; ++kq) s += modp[((size_t)kq * 16 + b) * 3072 + n];
    return s;
}
__device__ __forceinline__ void p1_h(const Args& a, int vcu, int G) {
    int tid_ = threadIdx.x; asm volatile("" : "+v"(tid_)); const int tid = tid_, lane = tid & 63, wave = __builtin_amdgcn_readfirstlane(tid >> 6);
    const float* x = (const float*)a.in[0]; const float* b_ada = (const float*)a.in[4]; const float* norm_pre = (const float*)a.in[5];
    const float* modp = (const float*)(a.ws + WS_MODP); bf16_t* H = (bf16_t*)(a.ws + WS_H);
    const int gw = vcu * NWAVES + wave, NGW = G * NWAVES;
    for (int grp = gw; grp < MTOT / 16; grp += NGW) {
        const int row0 = grp * 16, b = row0 / SEQ;
        f32x4 mul[4], add[4];
#pragma unroll
        for (int j = 0; j < 4; ++j)
#pragma unroll
            for (int e = 0; e < 4; ++e) { const int n = 256 * j + 4 * lane + e; mul[j][e] = norm_pre[n] * (1.0f + mod_at(modp, b_ada, b, 1024 + n)); add[j][e] = mod_at(modp, b_ada, b, n); }
        for (int rr = 0; rr < 16; ++rr) {
            const f32x4* xr = (const f32x4*)(x + (size_t)(row0 + rr) * DM) + lane;
            f32x4 v[4]; float s = 0.f;
#pragma unroll
            for (int j = 0; j < 4; ++j) { v[j] = xr[64 * j]; s += (v[j][0] * v[j][0] + v[j][1] * v[j][1]) + (v[j][2] * v[j][2] + v[j][3] * v[j][3]); }
            const float rstd = 1.0f / sqrtf(wave_sum(s) * (1.0f / DM) + EPS);
            u32x2* o8 = (u32x2*)(H + (size_t)(row0 + rr) * DM) + lane;
#pragma unroll
            for (int j = 0; j < 4; ++j) { const f32x4 y = v[j] * rstd * mul[j] + add[j]; o8[64 * j] = (u32x2){cvtpk(y[0], y[1]), cvtpk(y[2], y[3])}; }
        }
    }
}

__device__ __forceinline__ void p6_final(const Args& a, int chunk, int vcu, int G) {
    int tid_ = threadIdx.x; asm volatile("" : "+v"(tid_)); const int tid = tid_, lane = tid & 63, wave = __builtin_amdgcn_readfirstlane(tid >> 6);
    const float* x = (const float*)a.in[0]; const float* b_ada = (const float*)a.in[4]; const float* norm_post = (const float*)a.in[15];
    const float* modp = (const float*)(a.ws + WS_MODP); const float* rowss = (const float*)(a.ws + WS_ROWSS);
    const bf16_t* P = (const bf16_t*)(a.ws + WS_PROJ);
    const int gw = vcu * NWAVES + wave, NGW = G * NWAVES;
    for (int grp = gw; grp < MC / 16; grp += NGW) {
        const int lrow0 = grp * 16, row0 = chunk * MC + lrow0, b = row0 / SEQ;
        f32x4 gmul[4];
#pragma unroll
        for (int j = 0; j < 4; ++j)
#pragma unroll
            for (int e = 0; e < 4; ++e) { const int n = 256 * j + 4 * lane + e; gmul[j][e] = norm_post[n] * mod_at(modp, b_ada, b, 2048 + n); }
        for (int rr = 0; rr < 16; ++rr) {
            const float rstd = 1.0f / sqrtf(rowss[row0 + rr] * (1.0f / DM) + EPS);
            const f32x4* xr = (const f32x4*)(x + (size_t)(row0 + rr) * DM) + lane;
            const u32x2* yr = (const u32x2*)(P + (size_t)(lrow0 + rr) * NIN + C_Y) + lane;
            f32x4* orow = (f32x4*)(a.out + (size_t)(row0 + rr) * DM) + lane;
#pragma unroll
            for (int j = 0; j < 4; ++j) { const u32x2 yw = yr[64 * j]; const f32x4 y = {bflo(yw.x), bfhi(yw.x), bflo(yw.y), bfhi(yw.y)};
                orow[64 * j] = xr[64 * j] + y * rstd * gmul[j]; }
        }
    }
}
typedef short v4i16_t __attribute__((ext_vector_type(4)));
__device__ __forceinline__ s16x4 vtr(const LAS unsigned char* p) { return __builtin_bit_cast(s16x4, __builtin_amdgcn_ds_read_tr16_b64_v4i16((LAS v4i16_t*)p)); }
#define MFMA32(a, b, c) __builtin_amdgcn_mfma_f32_32x32x16_bf16((a), (b), (c), 0, 0, 0)
__device__ __forceinline__ int crow(int i, int hh) { return (i & 3) + 8 * (i >> 2) + 4 * hh; }
__device__ __forceinline__ bf16x8 pack8(const f32x16& x, int s) {
    u32x4 p; p.x = cvtpk(x[8 * s], x[8 * s + 1]); p.y = cvtpk(x[8 * s + 2], x[8 * s + 3]); p.z = cvtpk(x[8 * s + 4], x[8 * s + 5]); p.w = cvtpk(x[8 * s + 6], x[8 * s + 7]);
    return __builtin_bit_cast(bf16x8, p);
}
__device__ __forceinline__ bf16x8 cat4(s16x4 lo, s16x4 hi) { return (bf16x8){lo[0], lo[1], lo[2], lo[3], hi[0], hi[1], hi[2], hi[3]}; }

__device__ __forceinline__ void dsw_task(LAS unsigned char* wl, bf16_t* P, float* lse, int bl, int g, int hd, int sres, int n, int lane) {
    const int r = lane & 31, hh = lane >> 5, dsh = 2 * g, L = SEQ >> dsh, hc = (g * 8 + hd) * 64, l0 = n * 32;
    const size_t rowbase = (size_t)bl * SEQ;
    const int tokq = ((l0 + r) << dsh) + sres;
    bf16_t* qrow = P + (rowbase + tokq) * NIN + C_QA + hc;
    bf16x8 qf[4];
#pragma unroll
    for (int s = 0; s < 4; ++s) qf[s] = *(const bf16x8*)(qrow + 16 * s + 8 * hh);
    u32x4 vreg[3][4];
#pragma unroll
    for (int kb = 0; kb < 3; ++kb)
#pragma unroll
        for (int pc = 0; pc < 4; ++pc) { int lk = l0 - 64 + 32 * kb + 16 * (pc & 1) + (lane >> 2); lk = lk < 0 ? 0 : (lk >= L ? L - 1 : lk);
            vreg[kb][pc] = *(const u32x4*)(P + (rowbase + ((lk << dsh) + sres)) * NIN + C_VA + hc + (pc >> 1) * 32 + (lane & 3) * 8); }
    f32x16 S[5];
#pragma unroll
    for (int kb = 0; kb < 5; ++kb) {
        int lk = l0 - 64 + 32 * kb + r; lk = lk < 0 ? 0 : (lk >= L ? L - 1 : lk);
        const bf16_t* krow = P + (rowbase + ((lk << dsh) + sres)) * NIN + C_KA + hc + 8 * hh;
        bf16x8 kf[4];
#pragma unroll
        for (int s = 0; s < 4; ++s) kf[s] = *(const bf16x8*)(krow + 16 * s);
        f32x16 acc = {};
#pragma unroll
        for (int s = 0; s < 4; ++s) acc = MFMA32(kf[s], qf[s], acc);
        S[kb] = acc;
    }
#pragma unroll
    for (int kb = 0; kb < 3; ++kb)
#pragma unroll
        for (int pc = 0; pc < 4; ++pc) *(LAS u32x4*)(wl + kb * 4096 + pc * 1024 + lane * 16) = vreg[kb][pc];
#pragma unroll
    for (int kb = 3; kb < 5; ++kb)
#pragma unroll
        for (int pc = 0; pc < 4; ++pc) { int lk = l0 - 64 + 32 * kb + 16 * (pc & 1) + (lane >> 2); lk = lk < 0 ? 0 : (lk >= L ? L - 1 : lk);
            vreg[kb - 3][pc] = *(const u32x4*)(P + (rowbase + ((lk << dsh) + sres)) * NIN + C_VA + hc + (pc >> 1) * 32 + (lane & 3) * 8); }
    const int lq = l0 + r;
    float mx = -1e30f;
#pragma unroll
    for (int kb = 0; kb < 5; ++kb)
#pragma unroll
        for (int i = 0; i < 16; ++i) { const int lk = l0 - 64 + 32 * kb + crow(i, hh); const int d = lk - lq;
            const bool valid = (lk >= 0) && (lk < L) && (d <= 64) && (d >= -64);
            const float v = valid ? S[kb][i] : -1e30f; S[kb][i] = v; mx = fmaxf(mx, v); }
    mx = fmaxf(mx, __shfl_xor(mx, 32));
    float sum = 0.f;
#pragma unroll
    for (int kb = 0; kb < 5; ++kb)
#pragma unroll
        for (int i = 0; i < 16; ++i) { const float p = fexp2(S[kb][i] - mx); S[kb][i] = p; sum += p; }
    sum += __shfl_xor(sum, 32);
    f32x16 O[2]; O[0] = (f32x16){}; O[1] = (f32x16){};
    const LAS unsigned char* vb = wl + ((lane >> 4) & 1) * 32 + (lane & 3) * 8 + (4 * hh + ((lane & 15) >> 2)) * 64;
#pragma unroll
    for (int kb = 0; kb < 5; ++kb) {
        if (kb == 3) {
#pragma unroll
            for (int k2 = 0; k2 < 2; ++k2)
#pragma unroll
                for (int pc = 0; pc < 4; ++pc) *(LAS u32x4*)(wl + k2 * 4096 + pc * 1024 + lane * 16) = vreg[k2][pc];
        }
        const int slot = kb < 3 ? kb : kb - 3;
#pragma unroll
        for (int ks = 0; ks < 2; ++ks) {
            const bf16x8 pf = pack8(S[kb], ks);
#pragma unroll
            for (int d = 0; d < 2; ++d) {
                const s16x4 lo = vtr(vb + slot * 4096 + d * 2048 + ks * 1024), hi = vtr(vb + slot * 4096 + d * 2048 + ks * 1024 + 512);
                O[d] = MFMA32(cat4(lo, hi), pf, O[d]);
            }
        }
    }
    const float inv = 1.0f / sum;
#pragma unroll
    for (int d = 0; d < 2; ++d)
#pragma unroll
        for (int gq = 0; gq < 4; ++gq) {
            const u32x2 w = {cvtpk(O[d][4 * gq] * inv, O[d][4 * gq + 1] * inv), cvtpk(O[d][4 * gq + 2] * inv, O[d][4 * gq + 3] * inv)};
            *(u32x2*)(qrow + 32 * d + 8 * gq + 4 * hh) = w;
        }
    if (hh == 0) lse[(rowbase + tokq) * 24 + g * 8 + hd] = mx + log2f(sum);
}
__device__ __forceinline__ void dsw_unit(LAS unsigned char* lds, bf16_t* P, float* lse, bf16_t* Acat, int bl, int hd, int rq) {
    int tid_ = threadIdx.x; asm volatile("" : "+v"(tid_)); const int tid = tid_, lane = tid & 63, wave = __builtin_amdgcn_readfirstlane(tid >> 6);
    LAS unsigned char* wl = lds + wave * 12288;
    const int t0 = rq * 512;
#pragma unroll 1
    for (int g = 0; g < 3; ++g) {
        const int dil = 1 << (2 * g);
#pragma unroll 1
        for (int jj = 0; jj < 2; ++jj) { const int j = wave + 8 * jj; dsw_task(wl, P, lse, bl, g, hd, j % dil, (t0 / (32 * dil)) + j / dil, lane); }
    }
    __syncthreads();
    const size_t rowbase = (size_t)bl * SEQ + t0;
#pragma unroll 1
    for (int it = 0; it < 8; ++it) {
        const size_t row = rowbase + (tid >> 3) + 64 * it; const int piece = tid & 7;
        const float* lp = lse + row * 24 + hd;
        const float l0 = lp[0], l1 = lp[8], l2 = lp[16], mx = fmaxf(l0, fmaxf(l1, l2));
        float a0 = fexp2(l0 - mx), a1 = fexp2(l1 - mx), a2 = fexp2(l2 - mx); const float inv = 1.0f / (a0 + a1 + a2); a0 *= inv; a1 *= inv; a2 *= inv;
        const bf16_t* pr = P + row * NIN;
        const u32x4 o0 = *(const u32x4*)(pr + C_QA + hd * 64 + piece * 8), o1 = *(const u32x4*)(pr + C_QA + (8 + hd) * 64 + piece * 8), o2 = *(const u32x4*)(pr + C_QA + (16 + hd) * 64 + piece * 8);
        const u32x4 z = *(const u32x4*)(pr + C_ZA + hd * 64 + piece * 8);
        u32x4 w;
#define MRG(f) w.f = cvtpk((a0 * bflo(o0.f) + a1 * bflo(o1.f) + a2 * bflo(o2.f)) * bflo(z.f), (a0 * bfhi(o0.f) + a1 * bfhi(o1.f) + a2 * bfhi(o2.f)) * bfhi(z.f))
        MRG(x); MRG(y); MRG(z); MRG(w);
#undef MRG
        *(u32x4*)(Acat + row * KCAT + hd * 64 + piece * 8) = w;
    }
    __syncthreads();
}

constexpr float DIFF_THR = 6.0f;
__device__ __forceinline__ void diff_unit(LAS unsigned char* lds, const bf16_t* P, bf16_t* Acat, const float* subln, float lam, int bl, int h, int qb) {
    int tid_ = threadIdx.x; asm volatile("" : "+v"(tid_)); const int tid = tid_, lane = tid & 63, wave = __builtin_amdgcn_readfirstlane(tid >> 6);
    const int r = lane & 31, hh = lane >> 5, c = wave & 1, qi = wave >> 1;
    const size_t rowbase = (size_t)bl * SEQ;
    const size_t qrowi = rowbase + qb * 128 + qi * 32 + r;
    bf16x8 qf[4];
    { const bf16_t* qp = P + qrowi * NIN + C_QD + h * 128 + c * 64 + hh * 8;
#pragma unroll
      for (int s = 0; s < 4; ++s) qf[s] = *(const bf16x8*)(qp + 16 * s); }
    const bf16_t* ksrc[2]; const bf16_t* vsrc[2]; int kdst[2], vdst[2];
#pragma unroll
    for (int i = 0; i < 2; ++i) {
        const int ch = wave + 8 * i;
        ksrc[i] = P + (rowbase + lane) * NIN + C_KD + h * 128 + ch * 8; kdst[i] = (ch >> 3) * 8192 + (ch & 7) * 1024 + lane * 16;
        vsrc[i] = P + (rowbase + (ch & 3) * 16 + (lane >> 2)) * NIN + C_VD + h * 128 + (ch >> 2) * 32 + (lane & 3) * 8; vdst[i] = 16384 + ch * 1024 + lane * 16;
    }
    u32x4 kr[2], vr[2];
#pragma unroll
    for (int i = 0; i < 2; ++i) { kr[i] = *(const u32x4*)ksrc[i]; vr[i] = *(const u32x4*)vsrc[i]; }
#pragma unroll
    for (int i = 0; i < 2; ++i) { *(LAS u32x4*)(lds + kdst[i]) = kr[i]; *(LAS u32x4*)(lds + vdst[i]) = vr[i]; }
    __syncthreads();
    f32x16 O[4];
#pragma unroll
    for (int d = 0; d < 4; ++d) O[d] = (f32x16){};
    float m = -1e30f, l = 0.f;
    const int kfo = c * 8192 + hh * 1024 + r * 16;
    const int vfo = 16384 + ((lane >> 4) & 1) * 32 + (lane & 3) * 8 + (4 * hh + ((lane & 15) >> 2)) * 64;
    constexpr int NT = SEQ / 64;
#pragma unroll 1
    for (int t = 0; t < NT; ++t) {
        const int buf = (t & 1) * 32768;
        if (t + 1 < NT) {
#pragma unroll
            for (int i = 0; i < 2; ++i) { kr[i] = *(const u32x4*)(ksrc[i] + (size_t)(t + 1) * 64 * NIN); vr[i] = *(const u32x4*)(vsrc[i] + (size_t)(t + 1) * 64 * NIN); }
        }
        f32x16 S0 = {}, S1 = {};
        { const LAS unsigned char* kb = lds + buf + kfo;
#pragma unroll
          for (int s = 0; s < 4; ++s) { const bf16x8 k0 = *(const LAS bf16x8*)(kb + s * 2048), k1 = *(const LAS bf16x8*)(kb + s * 2048 + 512);
              S0 = MFMA32(k0, qf[s], S0); S1 = MFMA32(k1, qf[s], S1); } }
        float mx = fmaxf(S0[0], S1[0]);
#pragma unroll
        for (int i = 1; i < 16; ++i) mx = fmaxf(mx, fmaxf(S0[i], S1[i]));
        mx = fmaxf(mx, __shfl_xor(mx, 32));
        if (__any(mx > m + DIFF_THR)) {
            const float mn = fmaxf(m, mx), al = fexp2(m - mn);
            l *= al;
#pragma unroll
            for (int d = 0; d < 4; ++d) O[d] *= al;
            m = mn;
        }
        float ps = 0.f;
#pragma unroll
        for (int i = 0; i < 16; ++i) { S0[i] = fexp2(S0[i] - m); S1[i] = fexp2(S1[i] - m); ps += S0[i] + S1[i]; }
        l += ps;
        const LAS unsigned char* vb = lds + buf + vfo;
#pragma unroll
        for (int ks = 0; ks < 4; ++ks) {
            const bf16x8 pf = (ks < 2) ? pack8(S0, ks & 1) : pack8(S1, ks & 1);
#pragma unroll
            for (int d = 0; d < 4; ++d) {
                const s16x4 lo = vtr(vb + d * 4096 + ks * 1024), hi = vtr(vb + d * 4096 + ks * 1024 + 512);
                O[d] = MFMA32(cat4(lo, hi), pf, O[d]);
            }
        }
        if (t + 1 < NT) {
            const int nb = ((t + 1) & 1) * 32768;
#pragma unroll
            for (int i = 0; i < 2; ++i) { *(LAS u32x4*)(lds + nb + kdst[i]) = kr[i]; *(LAS u32x4*)(lds + nb + vdst[i]) = vr[i]; }
        }
        __syncthreads();
    }
    l += __shfl_xor(l, 32);
    LAS float* ex = (LAS float*)(lds + 65536) + qi * 4096 + lane;
    if (c == 1) {
        const float sc = lam / l;
#pragma unroll
        for (int d = 0; d < 4; ++d)
#pragma unroll
            for (int i = 0; i < 16; ++i) ex[(d * 16 + i) * 64] = O[d][i] * sc;
    }
    __syncthreads();
    if (c == 0) {
        const float inv = 1.0f / l; float ss = 0.f;
#pragma unroll
        for (int d = 0; d < 4; ++d)
#pragma unroll
            for (int i = 0; i < 16; ++i) { const float y = O[d][i] * inv - ex[(d * 16 + i) * 64]; O[d][i] = y; ss += y * y; }
        ss += __shfl_xor(ss, 32);
        const float rstd = 0.8f / sqrtf(ss * (1.0f / 128.0f) + EPS);
        const bf16_t* zrow = P + qrowi * NIN + C_ZD + h * 128; bf16_t* orow = Acat + qrowi * KCAT + 512 + h * 128;
#pragma unroll
        for (int d = 0; d < 4; ++d)
#pragma unroll
            for (int gq = 0; gq < 4; ++gq) { const int dim = 32 * d + 8 * gq + 4 * hh;
                const f32x4 w = *(const f32x4*)(subln + dim); const u32x2 z = *(const u32x2*)(zrow + dim);
                const u32x2 o = {cvtpk(O[d][4 * gq] * rstd * w[0] * bflo(z.x), O[d][4 * gq + 1] * rstd * w[1] * bfhi(z.x)), cvtpk(O[d][4 * gq + 2] * rstd * w[2] * bflo(z.y), O[d][4 * gq + 3] * rstd * w[3] * bfhi(z.y))};
                *(u32x2*)(orow + dim) = o; }
    }
    __syncthreads();
}
__global__ void __launch_bounds__(NWAVES * 64, 2) hybrid_fwd(Args args) {
    extern __shared__ __attribute__((aligned(16))) unsigned char lds_raw[];
    LAS unsigned char* lds = (LAS unsigned char*)lds_raw;
    cg::grid_group grid = cg::this_grid();
    const int G = gridDim.x, bx = blockIdx.x;
    const int vcu = (G % 8 == 0) ? (bx % 8) * (G / 8) + bx / 8 : bx;
    const int lo = args.ph_lo, hi = args.ph_hi;
    unsigned char* ws = args.ws;
#ifndef ONLY_KIND
#define ONLY_KIND -1
#endif
#ifndef KIND_MASK
#define KIND_MASK 0x7f
#endif
#define KIND(k) (((KIND_MASK >> (k)) & 1) && (ONLY_KIND < 0 || ONLY_KIND == (k)))
#define IN(k) (lo <= (k) && (k) < hi)
#define SEAM(k) do { if (IN(k) && IN((k) + 1)) grid.sync(); } while (0)
    if (KIND(0) && IN(0)) { p0_prologue(args, lds, vcu, G); }
    SEAM(0);
    if (KIND(1) && IN(1)) { p1_h(args, vcu, G); }
    SEAM(1);
    bf16_t* P = (bf16_t*)(ws + WS_PROJ); bf16_t* Acat = (bf16_t*)(ws + WS_ACAT); float* lse = (float*)(ws + WS_LSE);
#pragma unroll 1
    for (int ch = 0; ch < NCHUNK; ++ch) {
        const int pb = 2 + 5 * ch;
        if (KIND(2) && IN(pb)) {
            typedef pg8::Gemm<MC, NIN, DM, DM, DM> GT; typedef pg8::StaticOrder<MC, NIN> SO;
            GT g{(const bf16_t*)(ws + WS_H) + (size_t)ch * MC * DM, (const bf16_t*)(ws + WS_WIN)};
            SO S; S.init(G, bx);
            pg8::EpiIn E{P, (const float*)(ws + WS_TAB) + (size_t)ch * MC * 64};
            pg8::gemm_phase<pg8::EpiIn, SO, GT, true, true>(lds, g, S, E);
        }
        SEAM(pb);
        if (KIND(3) && IN(pb + 1)) {
            for (int u = vcu; u < BPC * 8 * 4; u += G) dsw_unit(lds, P, lse, Acat, u >> 5, (u >> 2) & 7, u & 3);
            const float lam = *(const float*)(ws + WS_LAM); const float* subln = (const float*)args.in[11];
            for (int u = vcu; u < BPC * 8 * 16; u += G) diff_unit(lds, P, Acat, subln, lam, u >> 7, (u >> 4) & 7, u & 15);
        }
        SEAM(pb + 1);
        if (KIND(4) && IN(pb + 2)) {
            typedef pg8::Gemm<MC, DM, KCAT, KCAT, KCAT> GT; typedef pg8::StaticOrder<MC, DM> SO;
            GT g{Acat, (const bf16_t*)(ws + WS_WCAT)};
            SO S; S.init(G, bx);
            pg8::EpiU E{P};
            pg8::gemm_phase<pg8::EpiU, SO, GT, true, true>(lds, g, S, E);
        }
        SEAM(pb + 2);
        if (KIND(5) && IN(pb + 3)) {
            typedef pg8::Gemm<MC, DM, DM, NIN, DM> GT; typedef pg8::StaticOrder<MC, DM> SO;
            GT g{P + C_U, (const bf16_t*)(ws + WS_WOUT)};
            SO S; S.init(G, bx);
            pg8::EpiY E{P, (float*)(ws + WS_ROWSS) + (size_t)ch * MC};
            pg8::gemm_phase<pg8::EpiY, SO, GT, true, true>(lds, g, S, E);
        }
        SEAM(pb + 3);
        if (KIND(6) && IN(pb + 4)) { p6_final(args, ch, vcu, G); }
        if (ch + 1 < NCHUNK) SEAM(pb + 4);
    }
#undef IN
#undef SEAM
}

#ifndef N_LAUNCH_MODE
#define N_LAUNCH_MODE 1
#endif
extern "C" void kernel_launch(void* const* d_in, const int* in_sizes, int n_in, void* d_out, int out_size, void* d_ws, size_t ws_size, hipStream_t stream) {
    static int grid = 0;
    if (grid == 0) {
        if (n_in != 16 || out_size != MTOT * DM || ws_size < WS_END) { fprintf(stderr, "kernel_launch: unexpected shapes: n_in %d out %d ws %zu (need %zu)\n", n_in, out_size, ws_size, (size_t)WS_END); grid = -1; return; }
        int dev = 0, cus = 0, per_cu = 0;
        hipGetDevice(&dev); hipDeviceGetAttribute(&cus, hipDeviceAttributeMultiprocessorCount, dev);
        if (hipFuncSetAttribute((const void*)hybrid_fwd, hipFuncAttributeMaxDynamicSharedMemorySize, LDS_BYTES) != hipSuccess) { fprintf(stderr, "kernel_launch: hipFuncSetAttribute failed\n"); grid = -1; return; }
        hipOccupancyMaxActiveBlocksPerMultiprocessor(&per_cu, (const void*)hybrid_fwd, NWAVES * 64, LDS_BYTES);
        (void)hipGetLastError();
        if (per_cu < 1) { fprintf(stderr, "kernel_launch: occupancy query says %d blocks per CU\n", per_cu); per_cu = 1; }
        grid = cus;
        fprintf(stderr, "kernel_launch: cus %d per_cu %d grid %d ws %zu\n", cus, per_cu, grid, ws_size);
    }
    if (grid < 0) return;
    Args a{};
    for (int i = 0; i < 16; ++i) a.in[i] = d_in[i];
    a.out = (float*)d_out; a.ws = (unsigned char*)d_ws;
#if N_LAUNCH_MODE == 1
    a.ph_lo = 0; a.ph_hi = N_PHASES;
    void* kargs[] = {&a};
    hipError_t e = hipLaunchCooperativeKernel((const void*)hybrid_fwd, dim3(grid), dim3(NWAVES * 64), kargs, LDS_BYTES, stream);
    if (e != hipSuccess) fprintf(stderr, "kernel_launch: cooperative launch failed: %s (grid %d)\n", hipGetErrorString(e), grid);
#else
    for (int p = 0; p < N_PHASES; ++p) {
        a.ph_lo = p; a.ph_hi = p + 1;
        hipLaunchKernelGGL(hybrid_fwd, dim3(grid), dim3(NWAVES * 64), LDS_BYTES, stream, a);
    }
#endif
}
```

```cpp
#include <hip/hip_runtime.h>
#include <hip/hip_cooperative_groups.h>
#include <cstdio>
#include <cstdint>
namespace cg = cooperative_groups;

constexpr int DM = 1024, NBATCH = 16, SEQ = 2048, MTOT = NBATCH * SEQ;
constexpr int NCHUNK = 2, MC = MTOT / NCHUNK, BPC = NBATCH / NCHUNK;
constexpr int NIN = 11264;
constexpr int C_QA = 0, C_KA = 1536, C_VA = 3072, C_ZA = 4608, C_QD = 5120, C_KD = 6144, C_VD = 7168, C_ZD = 8192, C_GA = 9216, C_GB = 10240;
constexpr int C_U = 0, C_Y = 1536;
constexpr int KCAT = 1536;
constexpr float QSCALE = 0.125f * 1.4426950408889634f;
constexpr float EPS = 1e-6f;
constexpr size_t MiB = 1u << 20;
constexpr size_t WS_MODP = 0;
constexpr size_t WS_LAM = 800 * 1024;
constexpr size_t WS_ROWSS = 832 * 1024;
constexpr size_t WS_BAR = 960 * 1024;
constexpr size_t WS_TAB = 1 * MiB;
constexpr size_t WS_WIN = 9 * MiB;
constexpr size_t WS_WCAT = 31 * MiB;
constexpr size_t WS_WOUT = 34 * MiB;
constexpr size_t WS_LSE = 36 * MiB;
constexpr size_t WS_H = 38 * MiB;
constexpr size_t WS_ACAT = 102 * MiB;
constexpr size_t WS_PROJ = 150 * MiB;
constexpr size_t WS_END = 502 * MiB;
constexpr int LDS_BYTES = 147456;
constexpr int NWAVES = 8;

#define LAS __attribute__((address_space(3)))
typedef unsigned short bf16_t;
typedef short bf16x8 __attribute__((ext_vector_type(8)));
typedef short s16x4 __attribute__((ext_vector_type(4)));
typedef float f32x4 __attribute__((ext_vector_type(4)));
typedef float f32x2 __attribute__((ext_vector_type(2)));
typedef float f32x16 __attribute__((ext_vector_type(16)));
typedef unsigned u32x4 __attribute__((ext_vector_type(4)));
typedef unsigned u32x2 __attribute__((ext_vector_type(2)));
typedef __bf16 bf16x2_t __attribute__((ext_vector_type(2)));
__device__ __forceinline__ unsigned cvtpk(float lo, float hi) { f32x2 v = {lo, hi}; bf16x2_t b = __builtin_convertvector(v, bf16x2_t); return __builtin_bit_cast(unsigned, b); }
__device__ __forceinline__ float bflo(unsigned w) { return __uint_as_float(w << 16); }
__device__ __forceinline__ float bfhi(unsigned w) { return __uint_as_float(w & 0xffff0000u); }
__device__ __forceinline__ float fexp2(float x) { return __builtin_amdgcn_exp2f(x); }
__device__ __forceinline__ float frcp(float x) { return __builtin_amdgcn_rcpf(x); }
__device__ __forceinline__ float sigmoidf_(float v) { return frcp(1.0f + fexp2(-1.4426950408889634f * v)); }
__device__ __forceinline__ float siluf_(float v) { return v * sigmoidf_(v); }

namespace pg8 {
#define PG8_LAS __attribute__((address_space(3)))
constexpr int BM = 256, BK = 64, HALF = 128, HTB = HALF * BK * 2  , STAGE_BYTES = 8 * HTB, NXCD = 8, WGM = 8;

__host__ __device__ __forceinline__ int lds_byte(int r, int c) { const int st = (r >> 4) * 2 + (c >> 5), rr = r & 15, cc = c & 31, ob = rr * 64 + cc * 2; return st * 1024 + (ob ^ (((ob >> 9) & 1) << 5)); }
__host__ __device__ __forceinline__ void stage_rc(int b, int& R, int& C) { const int st = b / 1024, sb = b % 1024, swz = sb ^ (((sb >> 9) & 1) << 5); R = (st >> 1) * 16 + swz / 64; C = (st & 1) * 32 + (swz % 64) / 2; }
__host__ __device__ __forceinline__ int perm32(int rho) { const int n = rho >> 4, i = rho & 15; return 8 * (i >> 2) + 4 * n + (i & 3); }

struct Unit { int pm, pn; };
template <int M_, int N_, int K_, int LDA_, int LDB_> struct Gemm { const bf16_t* A; const bf16_t* Bt; static constexpr int M = M_, N = N_, K = K_, lda = LDA_, ldb = LDB_; };

template <int M_, int N_> struct StaticOrder {
    static constexpr int nM = M_ / BM, nN = N_ / BM, nwg = nM * nN;
    int G, c;
    __host__ __device__ void init(int G_, int c_) { G = G_; c = c_; }
    __host__ __device__ bool next(int i, Unit& u) const {
        const int L = i * G + c; if (L >= nwg) return false;
        int wgid = L; { constexpr int q = nwg / NXCD, r = nwg % NXCD; const int xcd = wgid % NXCD, off = wgid / NXCD; wgid = (xcd < r ? xcd * (q + 1) : r * (q + 1) + (xcd - r) * q) + off; }
        constexpr int nig = WGM * nN; const int gid = wgid / nig, fm = gid * WGM, gsz = (nM - fm) < WGM ? (nM - fm) : WGM;
        u.pm = fm + ((wgid % nig) % gsz); u.pn = (wgid % nig) / gsz; return true;
    }
    __device__ __forceinline__ void a_ready(const Unit&) const {}
    __device__ __forceinline__ void done(const Unit&) const {}
};


template <class Epi, class Sched, class GemmT, bool ALIGN_EPI = false, bool SP2 = false>
__device__ __forceinline__ void gemm_phase(PG8_LAS unsigned char* lds, const GemmT g, const Sched& S, const Epi& E) {
    int tid_ = threadIdx.x; asm volatile("" : "+v"(tid_));
    const int tid = tid_, wid = __builtin_amdgcn_readfirstlane(tid >> 6), lane = tid & 63, wr = wid >> 2, wc = wid & 3, fr = lane & 15, fq = lane >> 4;
    constexpr int K = GemmT::K, nt = K / BK;
    unsigned voffA[2], voffB[2];
#pragma unroll
    for (int i = 0; i < 2; ++i) { int R, C; stage_rc(tid * 16 + i * 8192, R, C); const int Rb = Epi::PERM ? ((R & ~31) + perm32(R & 31)) : R;
        voffA[i] = (unsigned)(R * GemmT::lda + C) * 2u; voffB[i] = (unsigned)(Rb * GemmT::ldb + C) * 2u; }
    constexpr size_t kstep = (size_t)(BK * 2);
    constexpr size_t hstepA = (size_t)HALF * GemmT::lda * 2, hstepB = (size_t)HALF * GemmT::ldb * 2;
    constexpr size_t tstepA = 2 * hstepA, tstepB = 2 * hstepB;
    const unsigned ldsw = (unsigned)wid * 1024u;
    const int aoff = lds_byte(wr * 64 + fr, fq * 8), boff = lds_byte(wc * 32 + fr, fq * 8);
#define PG8_SA(b, h) (((b) * 2 + (h)) * HTB)
#define PG8_SB(b, h) ((4 + (b) * 2 + (h)) * HTB)
#define PG8_STAGE(bufoff, gbase, voff) do { _Pragma("unroll") for (int _i = 0; _i < 2; ++_i) \
        __builtin_amdgcn_global_load_lds((const unsigned*)((const char*)(gbase) + (voff)[_i]), (PG8_LAS unsigned*)(lds + (bufoff) + ldsw + _i * 8192), 16, 0, 0); } while (0)
#define PG8_LDA(dst, b, h) do { _Pragma("unroll") for (int m = 0; m < 4; ++m) _Pragma("unroll") for (int k = 0; k < 2; ++k) dst[m][k] = *(const PG8_LAS bf16x8*)(lds + PG8_SA(b, h) + aoff + m * 2048 + k * 1024); } while (0)
#define PG8_LDB(dst, b, h) do { _Pragma("unroll") for (int n = 0; n < 2; ++n) _Pragma("unroll") for (int k = 0; k < 2; ++k) dst[n][k] = *(const PG8_LAS bf16x8*)(lds + PG8_SB(b, h) + boff + n * 2048 + k * 1024); } while (0)
#define PG8_MMA(ai, bj, At, Bt) do { __builtin_amdgcn_s_setprio(1); _Pragma("unroll") for (int m = 0; m < 4; ++m) _Pragma("unroll") for (int n = 0; n < 2; ++n) _Pragma("unroll") for (int k = 0; k < 2; ++k) \
        acc[ai][bj][m][n] = __builtin_amdgcn_mfma_f32_16x16x32_bf16(Bt[n][k], At[m][k], acc[ai][bj][m][n], 0, 0, 0); __builtin_amdgcn_s_setprio(0); } while (0)
#define PG8_WAIT_V(n) asm volatile("s_waitcnt vmcnt(" #n ")" ::: "memory")
#define PG8_WAIT_L(n) asm volatile("s_waitcnt lgkmcnt(" #n ")" ::: "memory")
#define PG8_BAR __builtin_amdgcn_s_barrier()
#define PG8_SCHED __builtin_amdgcn_sched_barrier(0)
    Unit cur, nxt; int ui = 0;
    if (!S.next(0, cur)) return;
    f32x4 acc[2][2][4][2];
#pragma unroll
    for (int a = 0; a < 2; ++a)
#pragma unroll
        for (int b = 0; b < 2; ++b)
#pragma unroll
            for (int m = 0; m < 4; ++m)
#pragma unroll
                for (int n = 0; n < 2; ++n) acc[a][b][m][n] = (f32x4){0.f, 0.f, 0.f, 0.f};
    bf16x8 At[4][2], B0[2][2], B1[2][2];
    const char* cA = (const char*)g.A + (size_t)cur.pm * tstepA; const char* cB = (const char*)g.Bt + (size_t)cur.pn * tstepB;
    S.a_ready(cur);
    if constexpr (SP2) {
        PG8_STAGE(PG8_SB(0, 0), cB, voffB); PG8_STAGE(PG8_SB(0, 1), cB + hstepB, voffB); PG8_STAGE(PG8_SA(0, 0), cA, voffA); PG8_STAGE(PG8_SA(0, 1), cA + hstepA, voffA);
        if (wr == 1) PG8_BAR;
        PG8_WAIT_V(2); PG8_BAR;
        PG8_STAGE(PG8_SB(1, 0), cB + kstep, voffB); PG8_STAGE(PG8_SA(1, 0), cA + kstep, voffA); PG8_STAGE(PG8_SB(1, 1), cB + hstepB + kstep, voffB);
        PG8_WAIT_V(6); PG8_BAR;
    } else {
        PG8_STAGE(PG8_SB(0, 0), cB, voffB); PG8_STAGE(PG8_SA(0, 0), cA, voffA); PG8_STAGE(PG8_SB(0, 1), cB + hstepB, voffB); PG8_STAGE(PG8_SA(0, 1), cA + hstepA, voffA);
        if (wr == 1) PG8_BAR;
        PG8_WAIT_V(4); PG8_BAR;
        PG8_STAGE(PG8_SB(1, 0), cB + kstep, voffB); PG8_STAGE(PG8_SA(1, 0), cA + kstep, voffA); PG8_STAGE(PG8_SB(1, 1), cB + hstepB + kstep, voffB);
        PG8_WAIT_V(6); PG8_BAR;
    }
    for (;;) {
        const bool has_next = S.next(ui + 1, nxt);
        const char* nA = has_next ? (const char*)g.A + (size_t)nxt.pm * tstepA : cA; const char* nB = has_next ? (const char*)g.Bt + (size_t)nxt.pn * tstepB : cB;
        constexpr int NSEG = (Epi::MID_T > 0) ? 2 : 1;
#pragma unroll 1
        for (int seg = 0; seg < NSEG; ++seg) {
        const int t_beg = (seg == 0) ? 0 : Epi::MID_T, t_end = (NSEG == 2 && seg == 0) ? Epi::MID_T : nt;
#pragma unroll 1
        for (int t = t_beg; t < t_end; t += 2) {
            const bool last = (t == nt - 2);
            const char* a1 = cA + (size_t)(t + 1) * kstep;
            const char* a2 = last ? nA : cA + (size_t)(t + 2) * kstep; const char* b2 = last ? nB : cB + (size_t)(t + 2) * kstep;
            const char* a3 = a2 + kstep; const char* b3 = b2 + kstep;
            if (last && has_next) S.a_ready(nxt);
            if constexpr (SP2) {
            PG8_LDB(B0, 0, 0); PG8_LDB(B1, 0, 1); PG8_SCHED; PG8_LDA(At, 0, 0); PG8_STAGE(PG8_SA(1, 1), a1 + hstepA, voffA);
            PG8_WAIT_V(8); PG8_WAIT_L(0); PG8_BAR; PG8_MMA(0, 0, At, B0); PG8_MMA(0, 1, At, B1); PG8_BAR; PG8_SCHED;
            PG8_LDA(At, 0, 1); PG8_STAGE(PG8_SB(0, 0), b2, voffB); PG8_STAGE(PG8_SB(0, 1), b2 + hstepB, voffB); PG8_STAGE(PG8_SA(0, 0), a2, voffA);
            PG8_WAIT_V(8); PG8_WAIT_L(0); PG8_BAR; PG8_MMA(1, 0, At, B0); PG8_MMA(1, 1, At, B1); PG8_BAR; PG8_SCHED;
            PG8_LDB(B0, 1, 0); PG8_LDB(B1, 1, 1); PG8_SCHED; PG8_LDA(At, 1, 0); PG8_STAGE(PG8_SA(0, 1), a2 + hstepA, voffA);
            PG8_WAIT_V(8); PG8_WAIT_L(0); PG8_BAR; PG8_MMA(0, 0, At, B0); PG8_MMA(0, 1, At, B1); PG8_BAR; PG8_SCHED;
            PG8_LDA(At, 1, 1); PG8_STAGE(PG8_SB(1, 0), b3, voffB); PG8_STAGE(PG8_SB(1, 1), b3 + hstepB, voffB); PG8_STAGE(PG8_SA(1, 0), a3, voffA);
            PG8_WAIT_V(8); PG8_WAIT_L(0); PG8_BAR; PG8_MMA(1, 0, At, B0); PG8_MMA(1, 1, At, B1); PG8_BAR; PG8_SCHED;
            } else {
            PG8_LDB(B0, 0, 0); PG8_SCHED; PG8_LDA(At, 0, 0); PG8_STAGE(PG8_SA(1, 1), a1 + hstepA, voffA);
            PG8_WAIT_L(8); PG8_BAR; PG8_WAIT_L(0); PG8_MMA(0, 0, At, B0); PG8_BAR; PG8_SCHED;
            PG8_LDB(B1, 0, 1); PG8_STAGE(PG8_SB(0, 0), b2, voffB);
            PG8_BAR; PG8_WAIT_L(0); PG8_MMA(0, 1, At, B1); PG8_BAR;
            PG8_LDA(At, 0, 1); PG8_STAGE(PG8_SA(0, 0), a2, voffA);
            PG8_BAR; PG8_WAIT_L(0); PG8_MMA(1, 0, At, B0); PG8_BAR; PG8_SCHED;
            PG8_STAGE(PG8_SB(0, 1), b2 + hstepB, voffB);
            PG8_WAIT_V(6); PG8_BAR; PG8_MMA(1, 1, At, B1); PG8_BAR;
            PG8_LDB(B0, 1, 0); PG8_SCHED; PG8_LDA(At, 1, 0); PG8_STAGE(PG8_SA(0, 1), a2 + hstepA, voffA);
            PG8_WAIT_L(8); PG8_BAR; PG8_WAIT_L(0); PG8_MMA(0, 0, At, B0); PG8_BAR; PG8_SCHED;
            PG8_LDB(B1, 1, 1); PG8_STAGE(PG8_SB(1, 0), b3, voffB);
            PG8_BAR; PG8_WAIT_L(0); PG8_MMA(0, 1, At, B1); PG8_BAR;
            PG8_LDA(At, 1, 1); PG8_STAGE(PG8_SA(1, 0), a3, voffA);
            PG8_BAR; PG8_WAIT_L(0); PG8_MMA(1, 0, At, B0); PG8_BAR; PG8_SCHED;
            PG8_STAGE(PG8_SB(1, 1), b3 + hstepB, voffB);
            PG8_WAIT_V(6); PG8_BAR; PG8_MMA(1, 1, At, B1); PG8_BAR;
            }
        }
        if constexpr (NSEG == 2) { if (seg == 0) E.mid(acc, cur, wr, wc, fr, fq); }
        }
        if constexpr (ALIGN_EPI) { if (wr == 0) PG8_BAR; }
        if constexpr (!Epi::AFTER_DRAIN) { E(acc, cur, wr, wc, fr, fq); S.done(cur); }
        if (!has_next) break;
#pragma unroll
        for (int a = 0; a < 2; ++a)
#pragma unroll
            for (int b = 0; b < 2; ++b)
#pragma unroll
                for (int m = 0; m < 4; ++m)
#pragma unroll
                    for (int n = 0; n < 2; ++n) acc[a][b][m][n] = (f32x4){0.f, 0.f, 0.f, 0.f};
        cur = nxt; cA = nA; cB = nB; ++ui;
        if constexpr (ALIGN_EPI) { if (wr == 1) PG8_BAR; }
    }
    PG8_WAIT_V(0);
    if constexpr (!ALIGN_EPI) { if (wr == 0) PG8_BAR; }
    PG8_BAR;
    if constexpr (Epi::AFTER_DRAIN) { E.fused(acc, cur, wr, wc, fr, fq, lds, wid, lane); S.done(cur); }
#undef PG8_SA
#undef PG8_SB
#undef PG8_STAGE
#undef PG8_LDA
#undef PG8_LDB
#undef PG8_MMA
#undef PG8_WAIT_V
#undef PG8_WAIT_L
#undef PG8_BAR
#undef PG8_SCHED
}
}

namespace pg8 {
struct EpiIn {
    static constexpr bool PERM = true, AFTER_DRAIN = false; static constexpr int MID_T = 0;
    bf16_t* P; const float* tab;
    __device__ __forceinline__ void operator()(const f32x4 (&acc)[2][2][4][2], const Unit& u, int wr, int wc, int fr, int fq) const {
        const int pn = u.pn;
        int mode;
        if (pn < 6) mode = 1; else if (pn < 12) mode = 2; else if (pn < 18) mode = 0; else if (pn < 20) mode = 3; else if (pn < 24) mode = 1;
        else if (pn < 28) mode = 2; else if (pn < 32) mode = 0; else if (pn < 36) mode = 3; else mode = 4;
        int row0 = u.pm * BM + wr * 64 + fr, col0 = pn * BM + wc * 32 + 8 * fq;
        asm volatile("" : "+v"(row0), "+v"(col0));
#pragma unroll
        for (int ai = 0; ai < 2; ++ai)
#pragma unroll
            for (int m = 0; m < 4; ++m) {
                const int row = row0 + ai * HALF + m * 16;
                bf16_t* rowp = P + (size_t)row * NIN + col0;
#pragma unroll
                for (int bj = 0; bj < 2; ++bj) {
                    f32x4 v0 = acc[ai][bj][m][0], v1 = acc[ai][bj][m][1];
                    if (mode == 1 || mode == 2) {
                        const int f0 = ((col0 + bj * HALF) & 63) >> 1;
                        const float* tp = tab + ((size_t)row * 32 + f0) * 2;
                        const f32x4 c0 = *(const f32x4*)tp, c1 = *(const f32x4*)(tp + 4);
                        const float sc = (mode == 1) ? QSCALE : 1.0f;
                        f32x4 o0, o1;
                        o0[0] = (v0[0] * c0[0] - v0[1] * c0[1]) * sc; o0[1] = (v0[1] * c0[0] + v0[0] * c0[1]) * sc;
                        o0[2] = (v0[2] * c0[2] - v0[3] * c0[3]) * sc; o0[3] = (v0[3] * c0[2] + v0[2] * c0[3]) * sc;
                        o1[0] = (v1[0] * c1[0] - v1[1] * c1[1]) * sc; o1[1] = (v1[1] * c1[0] + v1[0] * c1[1]) * sc;
                        o1[2] = (v1[2] * c1[2] - v1[3] * c1[3]) * sc; o1[3] = (v1[3] * c1[2] + v1[2] * c1[3]) * sc;
                        v0 = o0; v1 = o1;
                    } else if (mode == 3) {
#pragma unroll
                        for (int e = 0; e < 4; ++e) { v0[e] = siluf_(v0[e]); v1[e] = siluf_(v1[e]); }
                    } else if (mode == 4) {
#pragma unroll
                        for (int e = 0; e < 4; ++e) { v0[e] = sigmoidf_(v0[e]); v1[e] = sigmoidf_(v1[e]); }
                    }
                    u32x4 w; w.x = cvtpk(v0[0], v0[1]); w.y = cvtpk(v0[2], v0[3]); w.z = cvtpk(v1[0], v1[1]); w.w = cvtpk(v1[2], v1[3]);
                    *(u32x4*)(rowp + bj * HALF) = w;
                }
            }
    }
};
struct EpiU {
    static constexpr bool PERM = true, AFTER_DRAIN = false; static constexpr int MID_T = 8;
    bf16_t* P;
    __device__ __forceinline__ void mid(f32x4 (&acc)[2][2][4][2], const Unit& u, int wr, int wc, int fr, int fq) const {
        int row0 = u.pm * BM + wr * 64 + fr, col0 = u.pn * BM + wc * 32 + 8 * fq;
        asm volatile("" : "+v"(row0), "+v"(col0));
#pragma unroll
        for (int ai = 0; ai < 2; ++ai)
#pragma unroll
            for (int m = 0; m < 4; ++m) {
                const bf16_t* rowp = P + (size_t)(row0 + ai * HALF + m * 16) * NIN + col0;
#pragma unroll
                for (int bj = 0; bj < 2; ++bj) {
                    const u32x4 a = *(const u32x4*)(rowp + C_GA + bj * HALF), b = *(const u32x4*)(rowp + C_GB + bj * HALF);
                    f32x4 r0, r1;
                    r0[0] = bflo(a.x) * frcp(bflo(b.x)); r0[1] = bfhi(a.x) * frcp(bfhi(b.x)); r0[2] = bflo(a.y) * frcp(bflo(b.y)); r0[3] = bfhi(a.y) * frcp(bfhi(b.y));
                    r1[0] = bflo(a.z) * frcp(bflo(b.z)); r1[1] = bfhi(a.z) * frcp(bfhi(b.z)); r1[2] = bflo(a.w) * frcp(bflo(b.w)); r1[3] = bfhi(a.w) * frcp(bfhi(b.w));
                    acc[ai][bj][m][0] *= r0; acc[ai][bj][m][1] *= r1;
                }
                if (m == 3) asm volatile("" ::: "memory");
            }
    }
    __device__ __forceinline__ void operator()(const f32x4 (&acc)[2][2][4][2], const Unit& u, int wr, int wc, int fr, int fq) const {
        int row0 = u.pm * BM + wr * 64 + fr, col0 = u.pn * BM + wc * 32 + 8 * fq;
        asm volatile("" : "+v"(row0), "+v"(col0));
#pragma unroll
        for (int ai = 0; ai < 2; ++ai)
#pragma unroll
            for (int m = 0; m < 4; ++m) {
                bf16_t* rowp = P + (size_t)(row0 + ai * HALF + m * 16) * NIN + col0;
#pragma unroll
                for (int bj = 0; bj < 2; ++bj) {
                    const u32x4 b = *(const u32x4*)(rowp + C_GB + bj * HALF);
                    const f32x4 v0 = acc[ai][bj][m][0], v1 = acc[ai][bj][m][1];
                    u32x4 w; w.x = cvtpk(v0[0] * bflo(b.x), v0[1] * bfhi(b.x)); w.y = cvtpk(v0[2] * bflo(b.y), v0[3] * bfhi(b.y));
                    w.z = cvtpk(v1[0] * bflo(b.z), v1[1] * bfhi(b.z)); w.w = cvtpk(v1[2] * bflo(b.w), v1[3] * bfhi(b.w));
                    *(u32x4*)(rowp + C_U + bj * HALF) = w;
                }
                if (m == 3) asm volatile("" ::: "memory");
            }
    }
};
struct EpiY {
    static constexpr bool PERM = true, AFTER_DRAIN = false; static constexpr int MID_T = 0;
    bf16_t* P; float* rowss;
    __device__ __forceinline__ void operator()(const f32x4 (&acc)[2][2][4][2], const Unit& u, int wr, int wc, int fr, int fq) const {
        int row0 = u.pm * BM + wr * 64 + fr, col0 = u.pn * BM + wc * 32 + 8 * fq;
        asm volatile("" : "+v"(row0), "+v"(col0));
#pragma unroll
        for (int ai = 0; ai < 2; ++ai)
#pragma unroll
            for (int m = 0; m < 4; ++m) {
                const int row = row0 + ai * HALF + m * 16;
                bf16_t* rowp = P + (size_t)row * NIN + C_Y + col0;
                float ss = 0.f;
#pragma unroll
                for (int bj = 0; bj < 2; ++bj) {
                    const f32x4 v0 = acc[ai][bj][m][0], v1 = acc[ai][bj][m][1];
                    ss += (v0[0] * v0[0] + v0[1] * v0[1]) + (v0[2] * v0[2] + v0[3] * v0[3]) + (v1[0] * v1[0] + v1[1] * v1[1]) + (v1[2] * v1[2] + v1[3] * v1[3]);
                    u32x4 w; w.x = cvtpk(v0[0], v0[1]); w.y = cvtpk(v0[2], v0[3]); w.z = cvtpk(v1[0], v1[1]); w.w = cvtpk(v1[2], v1[3]);
                    *(u32x4*)(rowp + bj * HALF) = w;
                }
                ss += __shfl_xor(ss, 16); ss += __shfl_xor(ss, 32);
                if (fq == 0) atomicAdd(rowss + row, ss);
            }
    }
};
}

__device__ __forceinline__ float wave_sum(float v) {
#pragma unroll
    for (int o = 1; o < 64; o <<= 1) v += __shfl_xor(v, o);
    return v;
}
__device__ __forceinline__ int win_dest_row(int n) {
    const bool rope = (n < C_VA) || (n >= C_QD && n < C_VD);
    if (!rope) return n;
    const int j = n & 63;
    return (n - j) + 2 * (j & 31) + (j >> 5);
}
template <bool PERMROWS>
__device__ __forceinline__ void transpose_item(const float* W, int N, bf16_t* WT, int ldk, int koff, LAS float* scr, int item, int lane) {
    const int nblk = N / 32, kb = item / nblk, nb = item % nblk, k0 = 64 * kb, n0 = 32 * nb;
#pragma unroll 8
    for (int i = 0; i < 32; ++i) { const int kk = 2 * i + (lane >> 5); scr[kk * 33 + (lane & 31)] = W[(size_t)(k0 + kk) * N + n0 + (lane & 31)]; }
    asm volatile("s_waitcnt lgkmcnt(0)" ::: "memory");
    const int c = lane & 7;
#pragma unroll
    for (int j = 0; j < 4; ++j) { const int n = (lane >> 3) + 8 * j; const LAS float* s = scr + (8 * c) * 33 + n;
        u32x4 o; o.x = cvtpk(s[0 * 33], s[1 * 33]); o.y = cvtpk(s[2 * 33], s[3 * 33]); o.z = cvtpk(s[4 * 33], s[5 * 33]); o.w = cvtpk(s[6 * 33], s[7 * 33]);
        const int dr = PERMROWS ? win_dest_row(n0 + n) : (n0 + n);
        *(u32x4*)(WT + (size_t)dr * ldk + koff + k0 + 8 * c) = o; }
    asm volatile("s_waitcnt lgkmcnt(0)" ::: "memory");
}
__device__ __forceinline__ void sincos_d(double a, float& s, float& c) {
    const double k = __builtin_rint(a * 0.63661977236758134308);
    const double r = __builtin_fma(-k, 6.123233995736766e-17, __builtin_fma(-k, 1.5707963267948966, a));
    const double r2 = r * r;
    double ps = -1.0 / 6227020800.0; ps = ps * r2 + 1.0 / 39916800.0; ps = ps * r2 - 1.0 / 362880.0; ps = ps * r2 + 1.0 / 5040.0; ps = ps * r2 - 1.0 / 120.0; ps = ps * r2 + 1.0 / 6.0; ps = -ps;
    const double sv = r + r * r2 * ps;
    double pc = 1.0 / 479001600.0; pc = pc * r2 - 1.0 / 3628800.0; pc = pc * r2 + 1.0 / 40320.0; pc = pc * r2 - 1.0 / 720.0; pc = pc * r2 + 1.0 / 24.0; pc = pc * r2 - 0.5;
    const double cv = 1.0 + r2 * pc;
    const int q = ((int)k) & 3;
    const double so = (q == 0) ? sv : (q == 1) ? cv : (q == 2) ? -sv : -cv;
    const double co = (q == 0) ? cv : (q == 1) ? -sv : (q == 2) ? -cv : sv;
    s = (float)so; c = (float)co;
}
struct Args { const void* in[16]; float* out; unsigned char* ws; int ph_lo, ph_hi; };
constexpr int N_PHASES = 2 + 5 * NCHUNK;

__device__ __forceinline__ void p0_prologue(const Args& a, LAS unsigned char* lds, int vcu, int G) {
    int tid_ = threadIdx.x; asm volatile("" : "+v"(tid_)); const int tid = tid_, lane = tid & 63, wave = __builtin_amdgcn_readfirstlane(tid >> 6);
    const float* c = (const float*)a.in[1]; const int* pos = (const int*)a.in[2];
    const float* w_ada = (const float*)a.in[3];
    const float* w_in = (const float*)a.in[6];
    const float* w_pa = (const float*)a.in[12]; const float* w_pb = (const float*)a.in[13]; const float* w_out = (const float*)a.in[14];
    unsigned char* ws = a.ws;
    {
        LAS float* sc = (LAS float*)lds;
        LAS float* red = (LAS float*)(lds + 16384);
        float* modp = (float*)(ws + WS_MODP);
        for (int it = vcu; it < 48 * 4; it += G) {
            const int cg_ = it >> 2, kq = it & 3, col = cg_ * 64 + lane;
            __syncthreads();
            for (int e = tid; e < 256 * 16; e += 512) { const int b = e >> 8, k = e & 255; sc[k * 16 + b] = siluf_(c[b * DM + kq * 256 + k]); }
            __syncthreads();
            float acc[16];
#pragma unroll
            for (int b = 0; b < 16; ++b) acc[b] = 0.f;
            const float* wp = w_ada + (size_t)(kq * 256 + wave * 32) * 3072 + col;
#pragma unroll 8
            for (int k = 0; k < 32; ++k) {
                const float w = wp[(size_t)k * 3072];
                const LAS f32x4* s4 = (const LAS f32x4*)(sc + (wave * 32 + k) * 16);
#pragma unroll
                for (int q = 0; q < 4; ++q) { const f32x4 s = s4[q]; acc[4 * q] += s[0] * w; acc[4 * q + 1] += s[1] * w; acc[4 * q + 2] += s[2] * w; acc[4 * q + 3] += s[3] * w; }
            }
#pragma unroll
            for (int b = 0; b < 16; ++b) red[(wave * 16 + b) * 64 + lane] = acc[b];
            __syncthreads();
            for (int e = tid; e < 16 * 64; e += 512) { const int b = e >> 6, cl = e & 63; float s = 0.f;
#pragma unroll
                for (int w = 0; w < 8; ++w) s += red[(w * 16 + b) * 64 + cl];
                modp[((size_t)kq * 16 + b) * 3072 + cg_ * 64 + cl] = s; }
        }
        __syncthreads();
    }
    const int gw = vcu * NWAVES + wave, NGW = G * NWAVES;
    {
        LAS float* scr = (LAS float*)(lds + wave * 16384);
        constexpr int I_IN = (DM / 64) * (NIN / 32), I_A = (512 / 64) * (DM / 32), I_B = (DM / 64) * (DM / 32), I_O = I_B;
        bf16_t* WinT = (bf16_t*)(ws + WS_WIN); bf16_t* WcatT = (bf16_t*)(ws + WS_WCAT); bf16_t* WoutT = (bf16_t*)(ws + WS_WOUT);
        for (int it = gw; it < I_IN + I_A + I_B + I_O; it += NGW) {
            int r = it;
            if (r < I_IN) { transpose_item<true>(w_in, NIN, WinT, DM, 0, scr, r, lane); continue; } r -= I_IN;
            if (r < I_A) { transpose_item<false>(w_pa, DM, WcatT, KCAT, 0, scr, r, lane); continue; } r -= I_A;
            if (r < I_B) { transpose_item<false>(w_pb, DM, WcatT, KCAT, 512, scr, r, lane); continue; } r -= I_B;
            transpose_item<false>(w_out, DM, WoutT, DM, 0, scr, r, lane);
        }
    }
    {
        float* tab = (float*)(ws + WS_TAB);
        const int gt = vcu * 512 + tid, NGT = G * 512;
        for (int e = gt; e < MTOT * 32; e += NGT) {
            const int tok = e >> 5, f = e & 31;
            const float inv = exp2f(-(float)f * (13.287712379549449f / 32.0f));
            const float ang = (float)pos[tok] * inv;
            float s, cs; sincos_d((double)ang, s, cs);
            *(f32x2*)(tab + (size_t)e * 2) = (f32x2){cs, s};
        }
        float* rowss = (float*)(ws + WS_ROWSS);
        for (int e = gt; e < MTOT; e += NGT) rowss[e] = 0.f;
        if (vcu == 0 && wave == 0) {
            const float* q1 = (const float*)a.in[7]; const float* k1 = (const float*)a.in[8]; const float* q2 = (const float*)a.in[9]; const float* k2 = (const float*)a.in[10];
            const float s1 = wave_sum(q1[lane] * k1[lane]), s2 = wave_sum(q2[lane] * k2[lane]);
            if (lane == 0) *(float*)(ws + WS_LAM) = expf(s1) - expf(s2) + 0.2f;
        }
    }
}

__device__ __forceinline__ float mod_at(const float* modp, const float* b_ada, int b, int n) {
    float s = b_ada[n];
#pragma unroll
    for (int kq = 0; kq < 4; ++kq) s += modp[((size_t)kq * 16 + b) * 3072 + n];
    return s;
}
__device__ __forceinline__ void p1_h(const Args& a, int vcu, int G) {
    int tid_ = threadIdx.x; asm volatile("" : "+v"(tid_)); const int tid = tid_, lane = tid & 63, wave = __builtin_amdgcn_readfirstlane(tid >> 6);
    const float* x = (const float*)a.in[0]; const float* b_ada = (const float*)a.in[4]; const float* norm_pre = (const float*)a.in[5];
    const float* modp = (const float*)(a.ws + WS_MODP); bf16_t* H = (bf16_t*)(a.ws + WS_H);
    const int gw = vcu * NWAVES + wave, NGW = G * NWAVES;
    for (int grp = gw; grp < MTOT / 16; grp += NGW) {
        const int row0 = grp * 16, b = row0 / SEQ;
        f32x4 mul[4], add[4];
#pragma unroll
        for (int j = 0; j < 4; ++j)
#pragma unroll
            for (int e = 0; e < 4; ++e) { const int n = 256 * j + 4 * lane + e; mul[j][e] = norm_pre[n] * (1.0f + mod_at(modp, b_ada, b, 1024 + n)); add[j][e] = mod_at(modp, b_ada, b, n); }
        for (int rr = 0; rr < 16; ++rr) {
            const f32x4* xr = (const f32x4*)(x + (size_t)(row0 + rr) * DM) + lane;
            f32x4 v[4]; float s = 0.f;
#pragma unroll
            for (int j = 0; j < 4; ++j) { v[j] = xr[64 * j]; s += (v[j][0] * v[j][0] + v[j][1] * v[j][1]) + (v[j][2] * v[j][2] + v[j][3] * v[j][3]); }
            const float rstd = 1.0f / sqrtf(wave_sum(s) * (1.0f / DM) + EPS);
            u32x2* o8 = (u32x2*)(H + (size_t)(row0 + rr) * DM) + lane;
#pragma unroll
            for (int j = 0; j < 4; ++j) { const f32x4 y = v[j] * rstd * mul[j] + add[j]; o8[64 * j] = (u32x2){cvtpk(y[0], y[1]), cvtpk(y[2], y[3])}; }
        }
    }
}

__device__ __forceinline__ void p6_final(const Args& a, int chunk, int vcu, int G) {
    int tid_ = threadIdx.x; asm volatile("" : "+v"(tid_)); const int tid = tid_, lane = tid & 63, wave = __builtin_amdgcn_readfirstlane(tid >> 6);
    const float* x = (const float*)a.in[0]; const float* b_ada = (const float*)a.in[4]; const float* norm_post = (const float*)a.in[15];
    const float* modp = (const float*)(a.ws + WS_MODP); const float* rowss = (const float*)(a.ws + WS_ROWSS);
    const bf16_t* P = (const bf16_t*)(a.ws + WS_PROJ);
    const int gw = vcu * NWAVES + wave, NGW = G * NWAVES;
    for (int grp = gw; grp < MC / 16; grp += NGW) {
        const int lrow0 = grp * 16, row0 = chunk * MC + lrow0, b = row0 / SEQ;
        f32x4 gmul[4];
#pragma unroll
        for (int j = 0; j < 4; ++j)
#pragma unroll
            for (int e = 0; e < 4; ++e) { const int n = 256 * j + 4 * lane + e; gmul[j][e] = norm_post[n] * mod_at(modp, b_ada, b, 2048 + n); }
        for (int rr = 0; rr < 16; ++rr) {
            const float rstd = 1.0f / sqrtf(rowss[row0 + rr] * (1.0f / DM) + EPS);
            const f32x4* xr = (const f32x4*)(x + (size_t)(row0 + rr) * DM) + lane;
            const u32x2* yr = (const u32x2*)(P + (size_t)(lrow0 + rr) * NIN + C_Y) + lane;
            f32x4* orow = (f32x4*)(a.out + (size_t)(row0 + rr) * DM) + lane;
#pragma unroll
            for (int j = 0; j < 4; ++j) { const u32x2 yw = yr[64 * j]; const f32x4 y = {bflo(yw.x), bfhi(yw.x), bflo(yw.y), bfhi(yw.y)};
                orow[64 * j] = xr[64 * j] + y * rstd * gmul[j]; }
        }
    }
}
typedef short v4i16_t __attribute__((ext_vector_type(4)));
__device__ __forceinline__ s16x4 vtr(const LAS unsigned char* p) { return __builtin_bit_cast(s16x4, __builtin_amdgcn_ds_read_tr16_b64_v4i16((LAS v4i16_t*)p)); }
#define MFMA32(a, b, c) __builtin_amdgcn_mfma_f32_32x32x16_bf16((a), (b), (c), 0, 0, 0)
__device__ __forceinline__ int crow(int i, int hh) { return (i & 3) + 8 * (i >> 2) + 4 * hh; }
__device__ __forceinline__ bf16x8 pack8(const f32x16& x, int s) {
    u32x4 p; p.x = cvtpk(x[8 * s], x[8 * s + 1]); p.y = cvtpk(x[8 * s + 2], x[8 * s + 3]); p.z = cvtpk(x[8 * s + 4], x[8 * s + 5]); p.w = cvtpk(x[8 * s + 6], x[8 * s + 7]);
    return __builtin_bit_cast(bf16x8, p);
}
#define SBAR() __builtin_amdgcn_sched_barrier(0)
__device__ __forceinline__ float xmax32(float v) { auto rr = __builtin_amdgcn_permlane32_swap(__float_as_uint(v), __float_as_uint(v), false, false); return fmaxf(__uint_as_float(rr[0]), __uint_as_float(rr[1])); }
__device__ __forceinline__ float xsum32(float v) { auto rr = __builtin_amdgcn_permlane32_swap(__float_as_uint(v), __float_as_uint(v), false, false); return __uint_as_float(rr[0]) + __uint_as_float(rr[1]); }
__device__ __forceinline__ bf16x8 cat4(s16x4 lo, s16x4 hi) { return (bf16x8){lo[0], lo[1], lo[2], lo[3], hi[0], hi[1], hi[2], hi[3]}; }

__device__ __forceinline__ void dsw_task(LAS unsigned char* wl, bf16_t* P, float* lse, int bl, int g, int hd, int sres, int n, int lane) {
    const int r = lane & 31, hh = lane >> 5, dsh = 2 * g, L = SEQ >> dsh, hc = (g * 8 + hd) * 64, l0 = n * 32;
    const size_t rowbase = (size_t)bl * SEQ;
    const int tokq = ((l0 + r) << dsh) + sres;
    bf16_t* qrow = P + (rowbase + tokq) * NIN + C_QA + hc;
    bf16x8 qf[4];
#pragma unroll
    for (int s = 0; s < 4; ++s) qf[s] = *(const bf16x8*)(qrow + 16 * s + 8 * hh);
    u32x4 vreg[3][4];
#pragma unroll
    for (int kb = 0; kb < 3; ++kb)
#pragma unroll
        for (int pc = 0; pc < 4; ++pc) { int lk = l0 - 64 + 32 * kb + 16 * (pc & 1) + (lane >> 2); lk = lk < 0 ? 0 : (lk >= L ? L - 1 : lk);
            vreg[kb][pc] = *(const u32x4*)(P + (rowbase + ((lk << dsh) + sres)) * NIN + C_VA + hc + (pc >> 1) * 32 + (lane & 3) * 8); }
    f32x16 S[5];
#pragma unroll
    for (int kb = 0; kb < 5; ++kb) {
        int lk = l0 - 64 + 32 * kb + r; lk = lk < 0 ? 0 : (lk >= L ? L - 1 : lk);
        const bf16_t* krow = P + (rowbase + ((lk << dsh) + sres)) * NIN + C_KA + hc + 8 * hh;
        bf16x8 kf[4];
#pragma unroll
        for (int s = 0; s < 4; ++s) kf[s] = *(const bf16x8*)(krow + 16 * s);
        f32x16 acc = {};
#pragma unroll
        for (int s = 0; s < 4; ++s) acc = MFMA32(kf[s], qf[s], acc);
        S[kb] = acc;
    }
#pragma unroll
    for (int kb = 0; kb < 3; ++kb)
#pragma unroll
        for (int pc = 0; pc < 4; ++pc) *(LAS u32x4*)(wl + kb * 4096 + pc * 1024 + lane * 16) = vreg[kb][pc];
#pragma unroll
    for (int kb = 3; kb < 5; ++kb)
#pragma unroll
        for (int pc = 0; pc < 4; ++pc) { int lk = l0 - 64 + 32 * kb + 16 * (pc & 1) + (lane >> 2); lk = lk < 0 ? 0 : (lk >= L ? L - 1 : lk);
            vreg[kb - 3][pc] = *(const u32x4*)(P + (rowbase + ((lk << dsh) + sres)) * NIN + C_VA + hc + (pc >> 1) * 32 + (lane & 3) * 8); }
    const int lq = l0 + r;
    float mx = -1e30f;
#pragma unroll
    for (int kb = 0; kb < 5; ++kb)
#pragma unroll
        for (int i = 0; i < 16; ++i) { const int lk = l0 - 64 + 32 * kb + crow(i, hh); const int d = lk - lq;
            const bool valid = (lk >= 0) && (lk < L) && (d <= 64) && (d >= -64);
            const float v = valid ? S[kb][i] : -1e30f; S[kb][i] = v; mx = fmaxf(mx, v); }
    mx = fmaxf(mx, __shfl_xor(mx, 32));
    float sum = 0.f;
#pragma unroll
    for (int kb = 0; kb < 5; ++kb)
#pragma unroll
        for (int i = 0; i < 16; ++i) { const float p = fexp2(S[kb][i] - mx); S[kb][i] = p; sum += p; }
    sum += __shfl_xor(sum, 32);
    f32x16 O[2]; O[0] = (f32x16){}; O[1] = (f32x16){};
    const LAS unsigned char* vb = wl + ((lane >> 4) & 1) * 32 + (lane & 3) * 8 + (4 * hh + ((lane & 15) >> 2)) * 64;
#pragma unroll
    for (int kb = 0; kb < 5; ++kb) {
        if (kb == 3) {
#pragma unroll
            for (int k2 = 0; k2 < 2; ++k2)
#pragma unroll
                for (int pc = 0; pc < 4; ++pc) *(LAS u32x4*)(wl + k2 * 4096 + pc * 1024 + lane * 16) = vreg[k2][pc];
        }
        const int slot = kb < 3 ? kb : kb - 3;
#pragma unroll
        for (int ks = 0; ks < 2; ++ks) {
            const bf16x8 pf = pack8(S[kb], ks);
#pragma unroll
            for (int d = 0; d < 2; ++d) {
                const s16x4 lo = vtr(vb + slot * 4096 + d * 2048 + ks * 1024), hi = vtr(vb + slot * 4096 + d * 2048 + ks * 1024 + 512);
                O[d] = MFMA32(cat4(lo, hi), pf, O[d]);
            }
        }
    }
    const float inv = 1.0f / sum;
#pragma unroll
    for (int d = 0; d < 2; ++d)
#pragma unroll
        for (int gq = 0; gq < 4; ++gq) {
            const u32x2 w = {cvtpk(O[d][4 * gq] * inv, O[d][4 * gq + 1] * inv), cvtpk(O[d][4 * gq + 2] * inv, O[d][4 * gq + 3] * inv)};
            *(u32x2*)(qrow + 32 * d + 8 * gq + 4 * hh) = w;
        }
    if (hh == 0) lse[(rowbase + tokq) * 24 + g * 8 + hd] = mx + log2f(sum);
}
__device__ __forceinline__ void dsw_unit(LAS unsigned char* lds, bf16_t* P, float* lse, bf16_t* Acat, int bl, int hd, int rq) {
    int tid_ = threadIdx.x; asm volatile("" : "+v"(tid_)); const int tid = tid_, lane = tid & 63, wave = __builtin_amdgcn_readfirstlane(tid >> 6);
    LAS unsigned char* wl = lds + wave * 12288;
    const int t0 = rq * 512;
#pragma unroll 1
    for (int g = 0; g < 3; ++g) {
        const int dil = 1 << (2 * g);
#pragma unroll 1
        for (int jj = 0; jj < 2; ++jj) { const int j = wave + 8 * jj; dsw_task(wl, P, lse, bl, g, hd, j % dil, (t0 / (32 * dil)) + j / dil, lane); }
    }
    __syncthreads();
    const size_t rowbase = (size_t)bl * SEQ + t0;
#pragma unroll 1
    for (int it = 0; it < 8; ++it) {
        const size_t row = rowbase + (tid >> 3) + 64 * it; const int piece = tid & 7;
        const float* lp = lse + row * 24 + hd;
        const float l0 = lp[0], l1 = lp[8], l2 = lp[16], mx = fmaxf(l0, fmaxf(l1, l2));
        float a0 = fexp2(l0 - mx), a1 = fexp2(l1 - mx), a2 = fexp2(l2 - mx); const float inv = 1.0f / (a0 + a1 + a2); a0 *= inv; a1 *= inv; a2 *= inv;
        const bf16_t* pr = P + row * NIN;
        const u32x4 o0 = *(const u32x4*)(pr + C_QA + hd * 64 + piece * 8), o1 = *(const u32x4*)(pr + C_QA + (8 + hd) * 64 + piece * 8), o2 = *(const u32x4*)(pr + C_QA + (16 + hd) * 64 + piece * 8);
        const u32x4 z = *(const u32x4*)(pr + C_ZA + hd * 64 + piece * 8);
        u32x4 w;
#define MRG(f) w.f = cvtpk((a0 * bflo(o0.f) + a1 * bflo(o1.f) + a2 * bflo(o2.f)) * bflo(z.f), (a0 * bfhi(o0.f) + a1 * bfhi(o1.f) + a2 * bfhi(o2.f)) * bfhi(z.f))
        MRG(x); MRG(y); MRG(z); MRG(w);
#undef MRG
        *(u32x4*)(Acat + row * KCAT + hd * 64 + piece * 8) = w;
    }
    __syncthreads();
}

constexpr float DIFF_THR = 6.0f;
__device__ __forceinline__ void diff_unit(LAS unsigned char* lds, const bf16_t* P, bf16_t* Acat, const float* subln, float lam, int bl, int h, int qb) {
    int tid_ = threadIdx.x; asm volatile("" : "+v"(tid_)); const int tid = tid_, lane = tid & 63, wave = __builtin_amdgcn_readfirstlane(tid >> 6);
    const int r = lane & 31, hh = lane >> 5, c = wave & 1, qi = wave >> 1;
    const size_t rowbase = (size_t)bl * SEQ;
    const size_t qrowi = rowbase + qb * 128 + qi * 32 + r;
    bf16x8 qf[4];
    { const bf16_t* qp = P + qrowi * NIN + C_QD + h * 128 + c * 64 + hh * 8;
#pragma unroll
      for (int s = 0; s < 4; ++s) qf[s] = *(const bf16x8*)(qp + 16 * s); }
    const bf16_t* ksrc[2]; const bf16_t* vsrc[2]; int kdst[2], vdst[2];
#pragma unroll
    for (int i = 0; i < 2; ++i) {
        const int p = tid + 512 * i, key = p >> 4, part = p & 15;
        ksrc[i] = P + (rowbase + key) * NIN + C_KD + h * 128 + part * 8; kdst[i] = (part >> 3) * 8320 + (part & 7) * 1040 + key * 16;
        vsrc[i] = P + (rowbase + key) * NIN + C_VD + h * 128 + part * 8; vdst[i] = 16640 + (part >> 2) * 4160 + (key >> 4) * 1024 + (key & 15) * 64 + (part & 3) * 16;
    }
    u32x4 kr[2], vr[2];
#pragma unroll
    for (int i = 0; i < 2; ++i) { kr[i] = *(const u32x4*)ksrc[i]; vr[i] = *(const u32x4*)vsrc[i]; }
#pragma unroll
    for (int i = 0; i < 2; ++i) { *(LAS u32x4*)(lds + kdst[i]) = kr[i]; *(LAS u32x4*)(lds + vdst[i]) = vr[i]; }
    __syncthreads();
    f32x16 O[4];
#pragma unroll
    for (int d = 0; d < 4; ++d) O[d] = (f32x16){};
    float m = -1e30f, l = 0.f;
    const int kfo = c * 8320 + hh * 1040 + r * 16;
    const int vfo = 16640 + ((lane >> 4) & 1) * 32 + (lane & 3) * 8 + (4 * hh + ((lane & 15) >> 2)) * 64;
    constexpr int NT = SEQ / 64;
#pragma unroll 1
    for (int t = 0; t < NT; ++t) {
        const int buf = (t & 1) * 33792;
        if (t + 1 < NT) {
#pragma unroll
            for (int i = 0; i < 2; ++i) { kr[i] = *(const u32x4*)(ksrc[i] + (size_t)(t + 1) * 64 * NIN); vr[i] = *(const u32x4*)(vsrc[i] + (size_t)(t + 1) * 64 * NIN); }
        }
        f32x16 S0 = {}, S1 = {};
        { const LAS unsigned char* kb = lds + buf + kfo;
          bf16x8 kf[8];
#pragma unroll
          for (int s = 0; s < 4; ++s) { kf[2 * s] = *(const LAS bf16x8*)(kb + s * 2080); kf[2 * s + 1] = *(const LAS bf16x8*)(kb + s * 2080 + 512); }
          SBAR();
#pragma unroll
          for (int s = 0; s < 4; ++s) { S0 = MFMA32(kf[2 * s], qf[s], S0); S1 = MFMA32(kf[2 * s + 1], qf[s], S1); } }
        const LAS unsigned char* vb = lds + buf + vfo;
        s16x4 vlo[2][4], vhi[2][4];
#pragma unroll
        for (int d = 0; d < 4; ++d) { vlo[0][d] = vtr(vb + d * 4160); vhi[0][d] = vtr(vb + d * 4160 + 512); }
        SBAR();
        float mx = fmaxf(S0[0], S1[0]);
#pragma unroll
        for (int i = 1; i < 16; ++i) mx = fmaxf(mx, fmaxf(S0[i], S1[i]));
        mx = xmax32(mx);
        if (__any(mx > m + DIFF_THR)) {
            const float mn = fmaxf(m, mx), al = fexp2(m - mn);
            l *= al;
#pragma unroll
            for (int d = 0; d < 4; ++d) O[d] *= al;
            m = mn;
        }
        float ps = 0.f;
#pragma unroll
        for (int i = 0; i < 16; ++i) { S0[i] = fexp2(S0[i] - m); S1[i] = fexp2(S1[i] - m); ps += S0[i] + S1[i]; }
        l += ps;
        SBAR();
#pragma unroll
        for (int ks = 0; ks < 4; ++ks) {
            if (ks < 3) {
#pragma unroll
                for (int d = 0; d < 4; ++d) { vlo[(ks + 1) & 1][d] = vtr(vb + d * 4160 + (ks + 1) * 1024); vhi[(ks + 1) & 1][d] = vtr(vb + d * 4160 + (ks + 1) * 1024 + 512); }
            }
            const bf16x8 pf = (ks < 2) ? pack8(S0, ks & 1) : pack8(S1, ks & 1);
            SBAR();
#pragma unroll
            for (int d = 0; d < 4; ++d) O[d] = MFMA32(cat4(vlo[ks & 1][d], vhi[ks & 1][d]), pf, O[d]);
            SBAR();
        }
        if (t + 1 < NT) {
            const int nb = ((t + 1) & 1) * 33792;
#pragma unroll
            for (int i = 0; i < 2; ++i) { *(LAS u32x4*)(lds + nb + kdst[i]) = kr[i]; *(LAS u32x4*)(lds + nb + vdst[i]) = vr[i]; }
        }
        __syncthreads();
    }
    l = xsum32(l);
    LAS float* ex = (LAS float*)(lds + 69632) + qi * 4096 + lane;
    if (c == 1) {
        const float sc = lam / l;
#pragma unroll
        for (int d = 0; d < 4; ++d)
#pragma unroll
            for (int i = 0; i < 16; ++i) ex[(d * 16 + i) * 64] = O[d][i] * sc;
    }
    __syncthreads();
    if (c == 0) {
        const float inv = 1.0f / l; float ss = 0.f;
#pragma unroll
        for (int d = 0; d < 4; ++d)
#pragma unroll
            for (int i = 0; i < 16; ++i) { const float y = O[d][i] * inv - ex[(d * 16 + i) * 64]; O[d][i] = y; ss += y * y; }
        ss = xsum32(ss);
        const float rstd = 0.8f / sqrtf(ss * (1.0f / 128.0f) + EPS);
        const bf16_t* zrow = P + qrowi * NIN + C_ZD + h * 128; bf16_t* orow = Acat + qrowi * KCAT + 512 + h * 128;
#pragma unroll
        for (int d = 0; d < 4; ++d)
#pragma unroll
            for (int gq = 0; gq < 4; ++gq) { const int dim = 32 * d + 8 * gq + 4 * hh;
                const f32x4 w = *(const f32x4*)(subln + dim); const u32x2 z = *(const u32x2*)(zrow + dim);
                const u32x2 o = {cvtpk(O[d][4 * gq] * rstd * w[0] * bflo(z.x), O[d][4 * gq + 1] * rstd * w[1] * bfhi(z.x)), cvtpk(O[d][4 * gq + 2] * rstd * w[2] * bflo(z.y), O[d][4 * gq + 3] * rstd * w[3] * bfhi(z.y))};
                *(u32x2*)(orow + dim) = o; }
    }
    __syncthreads();
}
#define XB_TMO      128
#define XB_XCNT(j)  (256  + 64 * (j))
#define XB_XSUB(j)  (1280 + 64 * (j))
#define XB_XGEN(j)  (2304 + 64 * (j))
#define XB_TOP      3328
#define XB_TOPGEN   3392
#define XCD_BAR_WORDS 3456
#define XB_SPIN_CAP (1u << 18)

__device__ __forceinline__ unsigned xb_ld(unsigned* p)              { return __hip_atomic_load(p, __ATOMIC_RELAXED, __HIP_MEMORY_SCOPE_AGENT); }
__device__ __forceinline__ unsigned xb_add(unsigned* p, unsigned v) { return __hip_atomic_fetch_add(p, v, __ATOMIC_RELAXED, __HIP_MEMORY_SCOPE_AGENT); }
__device__ __forceinline__ unsigned xb_xcc_id() { return (unsigned)__builtin_amdgcn_s_getreg((3 << 11) | 20) & 0xFu; }
#define XB_SPIN(cond, bar) do { unsigned _sp = 0; while (cond) { __builtin_amdgcn_s_sleep(1); \
    if ((++_sp & 255u) == 0u) { if (xb_ld(&(bar)[XB_TMO])) break; if (_sp > XB_SPIN_CAP) { atomicAdd(&(bar)[XB_TMO], 1u); break; } } } } while (0)

struct XcdBarrier {
    unsigned* bar; unsigned x;
    volatile LAS unsigned* st;
};

__device__ __forceinline__ XcdBarrier xcd_barrier_post(unsigned* bar, volatile LAS unsigned* st) {
    XcdBarrier b; b.bar = bar; b.x = xb_xcc_id(); b.st = st;
    if (threadIdx.x == 0) (void)xb_add(&bar[XB_XCNT(b.x)], 1u);
    return b;
}
__device__ __forceinline__ void xcd_barrier_complete(unsigned* bar, unsigned x, unsigned& nloc, unsigned& nx) {
    const unsigned G = gridDim.x * gridDim.y * gridDim.z;
    unsigned sum, cnt, mine, sp = 0u;
    for (;;) {
        sum = 0u; cnt = 0u; mine = 0u;
#pragma unroll
        for (unsigned j = 0; j < 16; ++j) { const unsigned c = xb_ld(&bar[XB_XCNT(j)]); sum += c; cnt += (c > 0u) ? 1u : 0u; mine = (j == x) ? c : mine; }
        if (sum == G) break;
        __builtin_amdgcn_s_sleep(1);
        if ((++sp & 255u) == 0u) { if (xb_ld(&bar[XB_TMO])) break; if (sp > XB_SPIN_CAP) { atomicAdd(&bar[XB_TMO], 1u); break; } }
    }
    nloc = mine > 0u ? mine : 1u; nx = cnt > 0u ? cnt : 1u;
}

__device__ __forceinline__ void xcd_barrier(const XcdBarrier& b) {
    asm volatile("s_waitcnt vmcnt(0)" ::: "memory");
    __syncthreads();
    if (threadIdx.x == 0) {
        unsigned* bar = b.bar;
        __builtin_amdgcn_s_waitcnt(0);
        unsigned nloc = b.st[0], nx = b.st[1];
        if (nloc == 0u) { xcd_barrier_complete(bar, b.x, nloc, nx); b.st[0] = nloc; b.st[1] = nx; }
        const unsigned old = xb_add(&bar[XB_XSUB(b.x)], 1u);
        const unsigned gen = old / nloc;
        if (old + 1u == (gen + 1u) * nloc) {
            __builtin_amdgcn_fence(__ATOMIC_RELEASE, "agent");
            asm volatile("s_waitcnt vmcnt(0)" ::: "memory");
            const unsigned og = xb_add(&bar[XB_TOP], 1u);
            const unsigned tg = og / nx;
            if (og + 1u == (tg + 1u) * nx) xb_add(&bar[XB_TOPGEN], 1u);
            else XB_SPIN(xb_ld(&bar[XB_TOPGEN]) == tg, bar);
            __builtin_amdgcn_fence(__ATOMIC_ACQUIRE, "agent");
            xb_add(&bar[XB_XGEN(b.x)], 1u);
            asm volatile("s_waitcnt vmcnt(0)" ::: "memory");
        } else {
            XB_SPIN(xb_ld(&bar[XB_XGEN(b.x)]) == gen, bar);
            __builtin_amdgcn_fence(__ATOMIC_ACQUIRE, "agent");
            asm volatile("s_waitcnt vmcnt(0)" ::: "memory");
        }
    }
    __syncthreads();
}

__global__ void __launch_bounds__(NWAVES * 64, 2) hybrid_fwd(Args args) {
    extern __shared__ __attribute__((aligned(16))) unsigned char lds_raw[];
    LAS unsigned char* lds = (LAS unsigned char*)lds_raw;
    cg::grid_group grid = cg::this_grid();
    const int G = gridDim.x, bx = blockIdx.x;
    const int vcu = (G % 8 == 0) ? (bx % 8) * (G / 8) + bx / 8 : bx;
    const int lo = args.ph_lo, hi = args.ph_hi;
    unsigned char* ws = args.ws;
#ifndef ONLY_KIND
#define ONLY_KIND -1
#endif
#ifndef KIND_MASK
#define KIND_MASK 0x7f
#endif
#define KIND(k) (((KIND_MASK >> (k)) & 1) && (ONLY_KIND < 0 || ONLY_KIND == (k)))
#define IN(k) (lo <= (k) && (k) < hi)
#ifndef REP_SYNC
#define REP_SYNC 1
#endif
#ifndef REP_EW
#define REP_EW 1
#endif
#define SEAM(k) do { if (IN(k) && IN((k) + 1)) { for (int rs_ = 0; rs_ < REP_SYNC; ++rs_) { if ((k) == 0) { grid.sync(); xbar = xcd_barrier_post(barw, (volatile LAS unsigned*)(lds + LDS_BYTES - 64)); } else xcd_barrier(xbar); } } } while (0)
    unsigned* barw = (unsigned*)(ws + WS_BAR);
    XcdBarrier xbar; xbar.bar = barw; xbar.x = 0; xbar.st = (volatile LAS unsigned*)(lds + LDS_BYTES - 64);
    if (threadIdx.x < 16) ((volatile LAS unsigned*)(lds + LDS_BYTES - 64))[threadIdx.x] = 0u;
    if (bx == 0) { for (int i = threadIdx.x; i < XCD_BAR_WORDS; i += NWAVES * 64) barw[i] = 0u; }
    __syncthreads();
    if (KIND(0) && IN(0)) { for (int rep = 0; rep < REP_EW; ++rep) { p0_prologue(args, lds, vcu, G); __syncthreads(); } }
    SEAM(0);
    if (KIND(1) && IN(1)) { for (int rep = 0; rep < REP_EW; ++rep) p1_h(args, vcu, G); }
    SEAM(1);
    bf16_t* P = (bf16_t*)(ws + WS_PROJ); bf16_t* Acat = (bf16_t*)(ws + WS_ACAT); float* lse = (float*)(ws + WS_LSE);
#pragma unroll 1
    for (int ch = 0; ch < NCHUNK; ++ch) {
        const int pb = 2 + 5 * ch;
        if (KIND(2) && IN(pb)) {
            typedef pg8::Gemm<MC, NIN, DM, DM, DM> GT; typedef pg8::StaticOrder<MC, NIN> SO;
            GT g{(const bf16_t*)(ws + WS_H) + (size_t)ch * MC * DM, (const bf16_t*)(ws + WS_WIN)};
            SO S; S.init(G, bx);
            pg8::EpiIn E{P, (const float*)(ws + WS_TAB) + (size_t)ch * MC * 64};
#ifndef REP_IN
#define REP_IN 1
#endif
#pragma unroll 1
            for (int rep = 0; rep < REP_IN; ++rep)
            pg8::gemm_phase<pg8::EpiIn, SO, GT, true, true>(lds, g, S, E);
        }
        SEAM(pb);
        if (KIND(3) && IN(pb + 1)) {
            for (int u = vcu; u < BPC * 8 * 4; u += G) dsw_unit(lds, P, lse, Acat, u >> 5, (u >> 2) & 7, u & 3);
            const float lam = *(const float*)(ws + WS_LAM); const float* subln = (const float*)args.in[11];
#ifndef REP_DIFF
#define REP_DIFF 1
#endif
#pragma unroll 1
            for (int rep = 0; rep < REP_DIFF; ++rep)
            for (int u = vcu; u < BPC * 8 * 16; u += G) diff_unit(lds, P, Acat, subln, lam, u >> 7, (u >> 4) & 7, u & 15);
        }
        SEAM(pb + 1);
        if (KIND(4) && IN(pb + 2)) {
            typedef pg8::Gemm<MC, DM, KCAT, KCAT, KCAT> GT; typedef pg8::StaticOrder<MC, DM> SO;
            GT g{Acat, (const bf16_t*)(ws + WS_WCAT)};
            SO S; S.init(G, bx);
            pg8::EpiU E{P};
#ifndef REP_AB
#define REP_AB 1
#endif
#pragma unroll 1
            for (int rep = 0; rep < REP_AB; ++rep)
            pg8::gemm_phase<pg8::EpiU, SO, GT, true, true>(lds, g, S, E);
        }
        SEAM(pb + 2);
        if (KIND(5) && IN(pb + 3)) {
            typedef pg8::Gemm<MC, DM, DM, NIN, DM> GT; typedef pg8::StaticOrder<MC, DM> SO;
            GT g{P + C_U, (const bf16_t*)(ws + WS_WOUT)};
            SO S; S.init(G, bx);
            pg8::EpiY E{P, (float*)(ws + WS_ROWSS) + (size_t)ch * MC};
            pg8::gemm_phase<pg8::EpiY, SO, GT, true, true>(lds, g, S, E);
        }
        SEAM(pb + 3);
        if (KIND(6) && IN(pb + 4)) { for (int rep = 0; rep < REP_EW; ++rep) p6_final(args, ch, vcu, G); }
        if (ch + 1 < NCHUNK) SEAM(pb + 4);
    }
#undef IN
#undef SEAM
}

#ifndef N_LAUNCH_MODE
#define N_LAUNCH_MODE 1
#endif
extern "C" void kernel_launch(void* const* d_in, const int* in_sizes, int n_in, void* d_out, int out_size, void* d_ws, size_t ws_size, hipStream_t stream) {
    static int grid = 0;
    if (grid == 0) {
        if (n_in != 16 || out_size != MTOT * DM || ws_size < WS_END) { fprintf(stderr, "kernel_launch: unexpected shapes: n_in %d out %d ws %zu (need %zu)\n", n_in, out_size, ws_size, (size_t)WS_END); grid = -1; return; }
        int dev = 0, cus = 0, per_cu = 0;
        hipGetDevice(&dev); hipDeviceGetAttribute(&cus, hipDeviceAttributeMultiprocessorCount, dev);
        if (hipFuncSetAttribute((const void*)hybrid_fwd, hipFuncAttributeMaxDynamicSharedMemorySize, LDS_BYTES) != hipSuccess) { fprintf(stderr, "kernel_launch: hipFuncSetAttribute failed\n"); grid = -1; return; }
        hipOccupancyMaxActiveBlocksPerMultiprocessor(&per_cu, (const void*)hybrid_fwd, NWAVES * 64, LDS_BYTES);
        (void)hipGetLastError();
        if (per_cu < 1) { fprintf(stderr, "kernel_launch: occupancy query says %d blocks per CU\n", per_cu); per_cu = 1; }
        grid = cus;
        fprintf(stderr, "kernel_launch: cus %d per_cu %d grid %d ws %zu\n", cus, per_cu, grid, ws_size);
    }
    if (grid < 0) return;
    Args a{};
    for (int i = 0; i < 16; ++i) a.in[i] = d_in[i];
    a.out = (float*)d_out; a.ws = (unsigned char*)d_ws;
#if N_LAUNCH_MODE == 1
    a.ph_lo = 0; a.ph_hi = N_PHASES;
    void* kargs[] = {&a};
    hipError_t e = hipLaunchCooperativeKernel((const void*)hybrid_fwd, dim3(grid), dim3(NWAVES * 64), kargs, LDS_BYTES, stream);
    if (e != hipSuccess) fprintf(stderr, "kernel_launch: cooperative launch failed: %s (grid %d)\n", hipGetErrorString(e), grid);
#else
    for (int p = 0; p < N_PHASES; ++p) {
        a.ph_lo = p; a.ph_hi = p + 1;
        hipLaunchKernelGGL(hybrid_fwd, dim3(grid), dim3(NWAVES * 64), LDS_BYTES, stream, a);
    }
#endif
}
```

```cpp
#include <hip/hip_runtime.h>
#include <hip/hip_cooperative_groups.h>
#include <cstdio>
#include <cstdint>
namespace cg = cooperative_groups;

constexpr int DM = 1024, NBATCH = 16, SEQ = 2048, MTOT = NBATCH * SEQ;
constexpr int NCHUNK = 2, MC = MTOT / NCHUNK, BPC = NBATCH / NCHUNK;
constexpr int NIN = 11264;
constexpr int C_QA = 0, C_KA = 1536, C_VA = 3072, C_ZA = 4608, C_QD = 5120, C_KD = 6144, C_VD = 7168, C_ZD = 8192, C_GA = 9216, C_GB = 10240;
constexpr int C_U = 0, C_Y = 1536;
constexpr int KCAT = 1536;
constexpr float QSCALE = 0.125f * 1.4426950408889634f;
constexpr float EPS = 1e-6f;
constexpr size_t MiB = 1u << 20;
constexpr size_t WS_MODP = 0;
constexpr size_t WS_LAM = 800 * 1024;
constexpr size_t WS_ROWSS = 832 * 1024;
constexpr size_t WS_BAR = 960 * 1024;
constexpr size_t WS_TAB = 1 * MiB;
constexpr size_t WS_WIN = 9 * MiB;
constexpr size_t WS_WCAT = 31 * MiB;
constexpr size_t WS_WOUT = 34 * MiB;
constexpr size_t WS_LSE = 36 * MiB;
constexpr size_t WS_H = 38 * MiB;
constexpr size_t WS_ACAT = 102 * MiB;
constexpr size_t WS_PROJ = 150 * MiB;
constexpr size_t WS_END = 502 * MiB;
constexpr int LDS_BYTES = 147456;
constexpr int NWAVES = 8;

#define LAS __attribute__((address_space(3)))
typedef unsigned short bf16_t;
typedef short bf16x8 __attribute__((ext_vector_type(8)));
typedef short s16x4 __attribute__((ext_vector_type(4)));
typedef float f32x4 __attribute__((ext_vector_type(4)));
typedef float f32x2 __attribute__((ext_vector_type(2)));
typedef float f32x16 __attribute__((ext_vector_type(16)));
typedef unsigned u32x4 __attribute__((ext_vector_type(4)));
typedef unsigned u32x2 __attribute__((ext_vector_type(2)));
typedef __bf16 bf16x2_t __attribute__((ext_vector_type(2)));
__device__ __forceinline__ unsigned cvtpk(float lo, float hi) { f32x2 v = {lo, hi}; bf16x2_t b = __builtin_convertvector(v, bf16x2_t); return __builtin_bit_cast(unsigned, b); }
__device__ __forceinline__ float bflo(unsigned w) { return __uint_as_float(w << 16); }
__device__ __forceinline__ float bfhi(unsigned w) { return __uint_as_float(w & 0xffff0000u); }
__device__ __forceinline__ float fexp2(float x) { return __builtin_amdgcn_exp2f(x); }
__device__ __forceinline__ float frcp(float x) { return __builtin_amdgcn_rcpf(x); }
__device__ __forceinline__ float sigmoidf_(float v) { return frcp(1.0f + fexp2(-1.4426950408889634f * v)); }
__device__ __forceinline__ float siluf_(float v) { return v * sigmoidf_(v); }

namespace pg8 {
#define PG8_LAS __attribute__((address_space(3)))
constexpr int BM = 256, BK = 64, HALF = 128, HTB = HALF * BK * 2  , STAGE_BYTES = 8 * HTB, NXCD = 8, WGM = 8;

__host__ __device__ __forceinline__ int lds_byte(int r, int c) { const int st = (r >> 4) * 2 + (c >> 5), rr = r & 15, cc = c & 31, ob = rr * 64 + cc * 2; return st * 1024 + (ob ^ (((ob >> 9) & 1) << 5)); }
__host__ __device__ __forceinline__ void stage_rc(int b, int& R, int& C) { const int st = b / 1024, sb = b % 1024, swz = sb ^ (((sb >> 9) & 1) << 5); R = (st >> 1) * 16 + swz / 64; C = (st & 1) * 32 + (swz % 64) / 2; }
__host__ __device__ __forceinline__ int perm32(int rho) { const int n = rho >> 4, i = rho & 15; return 8 * (i >> 2) + 4 * n + (i & 3); }

struct Unit { int pm, pn; };
template <int M_, int N_, int K_, int LDA_, int LDB_> struct Gemm { const bf16_t* A; const bf16_t* Bt; static constexpr int M = M_, N = N_, K = K_, lda = LDA_, ldb = LDB_; };

template <int M_, int N_> struct StaticOrder {
    static constexpr int nM = M_ / BM, nN = N_ / BM, nwg = nM * nN;
    int G, c;
    __host__ __device__ void init(int G_, int c_) { G = G_; c = c_; }
    __host__ __device__ bool next(int i, Unit& u) const {
        const int L = i * G + c; if (L >= nwg) return false;
        int wgid = L; { constexpr int q = nwg / NXCD, r = nwg % NXCD; const int xcd = wgid % NXCD, off = wgid / NXCD; wgid = (xcd < r ? xcd * (q + 1) : r * (q + 1) + (xcd - r) * q) + off; }
        constexpr int nig = WGM * nN; const int gid = wgid / nig, fm = gid * WGM, gsz = (nM - fm) < WGM ? (nM - fm) : WGM;
        u.pm = fm + ((wgid % nig) % gsz); u.pn = (wgid % nig) / gsz; return true;
    }
    __device__ __forceinline__ void a_ready(const Unit&) const {}
    __device__ __forceinline__ void done(const Unit&) const {}
};


template <class Epi, class Sched, class GemmT, bool ALIGN_EPI = false, bool SP2 = false>
__device__ __forceinline__ void gemm_phase(PG8_LAS unsigned char* lds, const GemmT g, const Sched& S, const Epi& E) {
    int tid_ = threadIdx.x; asm volatile("" : "+v"(tid_));
    const int tid = tid_, wid = __builtin_amdgcn_readfirstlane(tid >> 6), lane = tid & 63, wr = wid >> 2, wc = wid & 3, fr = lane & 15, fq = lane >> 4;
    constexpr int K = GemmT::K, nt = K / BK;
    unsigned voffA[2], voffB[2];
#pragma unroll
    for (int i = 0; i < 2; ++i) { int R, C; stage_rc(tid * 16 + i * 8192, R, C); const int Rb = Epi::PERM ? ((R & ~31) + perm32(R & 31)) : R;
        voffA[i] = (unsigned)(R * GemmT::lda + C) * 2u; voffB[i] = (unsigned)(Rb * GemmT::ldb + C) * 2u; }
    constexpr size_t kstep = (size_t)(BK * 2);
    constexpr size_t hstepA = (size_t)HALF * GemmT::lda * 2, hstepB = (size_t)HALF * GemmT::ldb * 2;
    constexpr size_t tstepA = 2 * hstepA, tstepB = 2 * hstepB;
    const unsigned ldsw = (unsigned)wid * 1024u;
    const int aoff = lds_byte(wr * 64 + fr, fq * 8), boff = lds_byte(wc * 32 + fr, fq * 8);
#define PG8_SA(b, h) (((b) * 2 + (h)) * HTB)
#define PG8_SB(b, h) ((4 + (b) * 2 + (h)) * HTB)
#define PG8_STAGE(bufoff, gbase, voff) do { _Pragma("unroll") for (int _i = 0; _i < 2; ++_i) \
        __builtin_amdgcn_global_load_lds((const unsigned*)((const char*)(gbase) + (voff)[_i]), (PG8_LAS unsigned*)(lds + (bufoff) + ldsw + _i * 8192), 16, 0, 0); } while (0)
#define PG8_LDA(dst, b, h) do { _Pragma("unroll") for (int m = 0; m < 4; ++m) _Pragma("unroll") for (int k = 0; k < 2; ++k) dst[m][k] = *(const PG8_LAS bf16x8*)(lds + PG8_SA(b, h) + aoff + m * 2048 + k * 1024); } while (0)
#define PG8_LDB(dst, b, h) do { _Pragma("unroll") for (int n = 0; n < 2; ++n) _Pragma("unroll") for (int k = 0; k < 2; ++k) dst[n][k] = *(const PG8_LAS bf16x8*)(lds + PG8_SB(b, h) + boff + n * 2048 + k * 1024); } while (0)
#define PG8_MMA(ai, bj, At, Bt) do { __builtin_amdgcn_s_setprio(1); _Pragma("unroll") for (int m = 0; m < 4; ++m) _Pragma("unroll") for (int n = 0; n < 2; ++n) _Pragma("unroll") for (int k = 0; k < 2; ++k) \
        acc[ai][bj][m][n] = __builtin_amdgcn_mfma_f32_16x16x32_bf16(Bt[n][k], At[m][k], acc[ai][bj][m][n], 0, 0, 0); __builtin_amdgcn_s_setprio(0); } while (0)
#define PG8_WAIT_V(n) asm volatile("s_waitcnt vmcnt(" #n ")" ::: "memory")
#define PG8_WAIT_L(n) asm volatile("s_waitcnt lgkmcnt(" #n ")" ::: "memory")
#define PG8_BAR __builtin_amdgcn_s_barrier()
#define PG8_SCHED __builtin_amdgcn_sched_barrier(0)
    Unit cur, nxt; int ui = 0;
    if (!S.next(0, cur)) return;
    f32x4 acc[2][2][4][2];
#pragma unroll
    for (int a = 0; a < 2; ++a)
#pragma unroll
        for (int b = 0; b < 2; ++b)
#pragma unroll
            for (int m = 0; m < 4; ++m)
#pragma unroll
                for (int n = 0; n < 2; ++n) acc[a][b][m][n] = (f32x4){0.f, 0.f, 0.f, 0.f};
    bf16x8 At[4][2], B0[2][2], B1[2][2];
    const char* cA = (const char*)g.A + (size_t)cur.pm * tstepA; const char* cB = (const char*)g.Bt + (size_t)cur.pn * tstepB;
    S.a_ready(cur);
    if constexpr (SP2) {
        PG8_STAGE(PG8_SB(0, 0), cB, voffB); PG8_STAGE(PG8_SB(0, 1), cB + hstepB, voffB); PG8_STAGE(PG8_SA(0, 0), cA, voffA); PG8_STAGE(PG8_SA(0, 1), cA + hstepA, voffA);
        if (wr == 1) PG8_BAR;
        PG8_WAIT_V(2); PG8_BAR;
        PG8_STAGE(PG8_SB(1, 0), cB + kstep, voffB); PG8_STAGE(PG8_SA(1, 0), cA + kstep, voffA); PG8_STAGE(PG8_SB(1, 1), cB + hstepB + kstep, voffB);
        PG8_WAIT_V(6); PG8_BAR;
    } else {
        PG8_STAGE(PG8_SB(0, 0), cB, voffB); PG8_STAGE(PG8_SA(0, 0), cA, voffA); PG8_STAGE(PG8_SB(0, 1), cB + hstepB, voffB); PG8_STAGE(PG8_SA(0, 1), cA + hstepA, voffA);
        if (wr == 1) PG8_BAR;
        PG8_WAIT_V(4); PG8_BAR;
        PG8_STAGE(PG8_SB(1, 0), cB + kstep, voffB); PG8_STAGE(PG8_SA(1, 0), cA + kstep, voffA); PG8_STAGE(PG8_SB(1, 1), cB + hstepB + kstep, voffB);
        PG8_WAIT_V(6); PG8_BAR;
    }
    for (;;) {
        const bool has_next = S.next(ui + 1, nxt);
        const char* nA = has_next ? (const char*)g.A + (size_t)nxt.pm * tstepA : cA; const char* nB = has_next ? (const char*)g.Bt + (size_t)nxt.pn * tstepB : cB;
        constexpr int NSEG = (Epi::MID_T > 0) ? 2 : 1;
#pragma unroll 1
        for (int seg = 0; seg < NSEG; ++seg) {
        const int t_beg = (seg == 0) ? 0 : Epi::MID_T, t_end = (NSEG == 2 && seg == 0) ? Epi::MID_T : nt;
#pragma unroll 1
        for (int t = t_beg; t < t_end; t += 2) {
            const bool last = (t == nt - 2);
            const char* a1 = cA + (size_t)(t + 1) * kstep;
            const char* a2 = last ? nA : cA + (size_t)(t + 2) * kstep; const char* b2 = last ? nB : cB + (size_t)(t + 2) * kstep;
            const char* a3 = a2 + kstep; const char* b3 = b2 + kstep;
            if (last && has_next) S.a_ready(nxt);
            if constexpr (SP2) {
            PG8_LDB(B0, 0, 0); PG8_LDB(B1, 0, 1); PG8_SCHED; PG8_LDA(At, 0, 0); PG8_STAGE(PG8_SA(1, 1), a1 + hstepA, voffA);
            PG8_WAIT_V(8); PG8_WAIT_L(0); PG8_BAR; PG8_MMA(0, 0, At, B0); PG8_MMA(0, 1, At, B1); PG8_BAR; PG8_SCHED;
            PG8_LDA(At, 0, 1); PG8_STAGE(PG8_SB(0, 0), b2, voffB); PG8_STAGE(PG8_SB(0, 1), b2 + hstepB, voffB); PG8_STAGE(PG8_SA(0, 0), a2, voffA);
            PG8_WAIT_V(8); PG8_WAIT_L(0); PG8_BAR; PG8_MMA(1, 0, At, B0); PG8_MMA(1, 1, At, B1); PG8_BAR; PG8_SCHED;
            PG8_LDB(B0, 1, 0); PG8_LDB(B1, 1, 1); PG8_SCHED; PG8_LDA(At, 1, 0); PG8_STAGE(PG8_SA(0, 1), a2 + hstepA, voffA);
            PG8_WAIT_V(8); PG8_WAIT_L(0); PG8_BAR; PG8_MMA(0, 0, At, B0); PG8_MMA(0, 1, At, B1); PG8_BAR; PG8_SCHED;
            PG8_LDA(At, 1, 1); PG8_STAGE(PG8_SB(1, 0), b3, voffB); PG8_STAGE(PG8_SB(1, 1), b3 + hstepB, voffB); PG8_STAGE(PG8_SA(1, 0), a3, voffA);
            PG8_WAIT_V(8); PG8_WAIT_L(0); PG8_BAR; PG8_MMA(1, 0, At, B0); PG8_MMA(1, 1, At, B1); PG8_BAR; PG8_SCHED;
            } else {
            PG8_LDB(B0, 0, 0); PG8_SCHED; PG8_LDA(At, 0, 0); PG8_STAGE(PG8_SA(1, 1), a1 + hstepA, voffA);
            PG8_WAIT_L(8); PG8_BAR; PG8_WAIT_L(0); PG8_MMA(0, 0, At, B0); PG8_BAR; PG8_SCHED;
            PG8_LDB(B1, 0, 1); PG8_STAGE(PG8_SB(0, 0), b2, voffB);
            PG8_BAR; PG8_WAIT_L(0); PG8_MMA(0, 1, At, B1); PG8_BAR;
            PG8_LDA(At, 0, 1); PG8_STAGE(PG8_SA(0, 0), a2, voffA);
            PG8_BAR; PG8_WAIT_L(0); PG8_MMA(1, 0, At, B0); PG8_BAR; PG8_SCHED;
            PG8_STAGE(PG8_SB(0, 1), b2 + hstepB, voffB);
            PG8_WAIT_V(6); PG8_BAR; PG8_MMA(1, 1, At, B1); PG8_BAR;
            PG8_LDB(B0, 1, 0); PG8_SCHED; PG8_LDA(At, 1, 0); PG8_STAGE(PG8_SA(0, 1), a2 + hstepA, voffA);
            PG8_WAIT_L(8); PG8_BAR; PG8_WAIT_L(0); PG8_MMA(0, 0, At, B0); PG8_BAR; PG8_SCHED;
            PG8_LDB(B1, 1, 1); PG8_STAGE(PG8_SB(1, 0), b3, voffB);
            PG8_BAR; PG8_WAIT_L(0); PG8_MMA(0, 1, At, B1); PG8_BAR;
            PG8_LDA(At, 1, 1); PG8_STAGE(PG8_SA(1, 0), a3, voffA);
            PG8_BAR; PG8_WAIT_L(0); PG8_MMA(1, 0, At, B0); PG8_BAR; PG8_SCHED;
            PG8_STAGE(PG8_SB(1, 1), b3 + hstepB, voffB);
            PG8_WAIT_V(6); PG8_BAR; PG8_MMA(1, 1, At, B1); PG8_BAR;
            }
        }
        if constexpr (NSEG == 2) { if (seg == 0) E.mid(acc, cur, wr, wc, fr, fq); }
        }
        if constexpr (ALIGN_EPI) { if (wr == 0) PG8_BAR; }
        if constexpr (!Epi::AFTER_DRAIN) { E(acc, cur, wr, wc, fr, fq); S.done(cur); }
        if (!has_next) break;
#pragma unroll
        for (int a = 0; a < 2; ++a)
#pragma unroll
            for (int b = 0; b < 2; ++b)
#pragma unroll
                for (int m = 0; m < 4; ++m)
#pragma unroll
                    for (int n = 0; n < 2; ++n) acc[a][b][m][n] = (f32x4){0.f, 0.f, 0.f, 0.f};
        cur = nxt; cA = nA; cB = nB; ++ui;
        if constexpr (ALIGN_EPI) { if (wr == 1) PG8_BAR; }
    }
    PG8_WAIT_V(0);
    if constexpr (!ALIGN_EPI) { if (wr == 0) PG8_BAR; }
    PG8_BAR;
    if constexpr (Epi::AFTER_DRAIN) { E.fused(acc, cur, wr, wc, fr, fq, lds, wid, lane); S.done(cur); }
#undef PG8_SA
#undef PG8_SB
#undef PG8_STAGE
#undef PG8_LDA
#undef PG8_LDB
#undef PG8_MMA
#undef PG8_WAIT_V
#undef PG8_WAIT_L
#undef PG8_BAR
#undef PG8_SCHED
}
}

namespace pg8 {
struct EpiIn {
    static constexpr bool PERM = true, AFTER_DRAIN = false; static constexpr int MID_T = 0;
    bf16_t* P; const float* tab;
    __device__ __forceinline__ void operator()(const f32x4 (&acc)[2][2][4][2], const Unit& u, int wr, int wc, int fr, int fq) const {
        const int pn = u.pn;
        int mode;
        if (pn < 6) mode = 1; else if (pn < 12) mode = 2; else if (pn < 18) mode = 0; else if (pn < 20) mode = 3; else if (pn < 24) mode = 1;
        else if (pn < 28) mode = 2; else if (pn < 32) mode = 0; else if (pn < 36) mode = 3; else mode = 4;
        int row0 = u.pm * BM + wr * 64 + fr, col0 = pn * BM + wc * 32 + 8 * fq;
        asm volatile("" : "+v"(row0), "+v"(col0));
#pragma unroll
        for (int ai = 0; ai < 2; ++ai)
#pragma unroll
            for (int m = 0; m < 4; ++m) {
                const int row = row0 + ai * HALF + m * 16;
                bf16_t* rowp = P + (size_t)row * NIN + col0;
#pragma unroll
                for (int bj = 0; bj < 2; ++bj) {
                    f32x4 v0 = acc[ai][bj][m][0], v1 = acc[ai][bj][m][1];
                    if (mode == 1 || mode == 2) {
                        const int f0 = ((col0 + bj * HALF) & 63) >> 1;
                        const float* tp = tab + ((size_t)row * 32 + f0) * 2;
                        const f32x4 c0 = *(const f32x4*)tp, c1 = *(const f32x4*)(tp + 4);
                        const float sc = (mode == 1) ? QSCALE : 1.0f;
                        f32x4 o0, o1;
                        o0[0] = (v0[0] * c0[0] - v0[1] * c0[1]) * sc; o0[1] = (v0[1] * c0[0] + v0[0] * c0[1]) * sc;
                        o0[2] = (v0[2] * c0[2] - v0[3] * c0[3]) * sc; o0[3] = (v0[3] * c0[2] + v0[2] * c0[3]) * sc;
                        o1[0] = (v1[0] * c1[0] - v1[1] * c1[1]) * sc; o1[1] = (v1[1] * c1[0] + v1[0] * c1[1]) * sc;
                        o1[2] = (v1[2] * c1[2] - v1[3] * c1[3]) * sc; o1[3] = (v1[3] * c1[2] + v1[2] * c1[3]) * sc;
                        v0 = o0; v1 = o1;
                    } else if (mode == 3) {
#pragma unroll
                        for (int e = 0; e < 4; ++e) { v0[e] = siluf_(v0[e]); v1[e] = siluf_(v1[e]); }
                    } else if (mode == 4) {
#pragma unroll
                        for (int e = 0; e < 4; ++e) { v0[e] = sigmoidf_(v0[e]); v1[e] = sigmoidf_(v1[e]); }
                    }
                    u32x4 w; w.x = cvtpk(v0[0], v0[1]); w.y = cvtpk(v0[2], v0[3]); w.z = cvtpk(v1[0], v1[1]); w.w = cvtpk(v1[2], v1[3]);
                    *(u32x4*)(rowp + bj * HALF) = w;
                }
            }
    }
};
struct EpiU {
    static constexpr bool PERM = true, AFTER_DRAIN = false; static constexpr int MID_T = 8;
    bf16_t* P;
    __device__ __forceinline__ void mid(f32x4 (&acc)[2][2][4][2], const Unit& u, int wr, int wc, int fr, int fq) const {
        int row0 = u.pm * BM + wr * 64 + fr, col0 = u.pn * BM + wc * 32 + 8 * fq;
        asm volatile("" : "+v"(row0), "+v"(col0));
#pragma unroll
        for (int ai = 0; ai < 2; ++ai)
#pragma unroll
            for (int m = 0; m < 4; ++m) {
                const bf16_t* rowp = P + (size_t)(row0 + ai * HALF + m * 16) * NIN + col0;
#pragma unroll
                for (int bj = 0; bj < 2; ++bj) {
                    const u32x4 a = *(const u32x4*)(rowp + C_GA + bj * HALF), b = *(const u32x4*)(rowp + C_GB + bj * HALF);
                    f32x4 r0, r1;
                    r0[0] = bflo(a.x) * frcp(bflo(b.x)); r0[1] = bfhi(a.x) * frcp(bfhi(b.x)); r0[2] = bflo(a.y) * frcp(bflo(b.y)); r0[3] = bfhi(a.y) * frcp(bfhi(b.y));
                    r1[0] = bflo(a.z) * frcp(bflo(b.z)); r1[1] = bfhi(a.z) * frcp(bfhi(b.z)); r1[2] = bflo(a.w) * frcp(bflo(b.w)); r1[3] = bfhi(a.w) * frcp(bfhi(b.w));
                    acc[ai][bj][m][0] *= r0; acc[ai][bj][m][1] *= r1;
                }
                if (m == 3) asm volatile("" ::: "memory");
            }
    }
    __device__ __forceinline__ void operator()(const f32x4 (&acc)[2][2][4][2], const Unit& u, int wr, int wc, int fr, int fq) const {
        int row0 = u.pm * BM + wr * 64 + fr, col0 = u.pn * BM + wc * 32 + 8 * fq;
        asm volatile("" : "+v"(row0), "+v"(col0));
#pragma unroll
        for (int ai = 0; ai < 2; ++ai)
#pragma unroll
            for (int m = 0; m < 4; ++m) {
                bf16_t* rowp = P + (size_t)(row0 + ai * HALF + m * 16) * NIN + col0;
#pragma unroll
                for (int bj = 0; bj < 2; ++bj) {
                    const u32x4 b = *(const u32x4*)(rowp + C_GB + bj * HALF);
                    const f32x4 v0 = acc[ai][bj][m][0], v1 = acc[ai][bj][m][1];
                    u32x4 w; w.x = cvtpk(v0[0] * bflo(b.x), v0[1] * bfhi(b.x)); w.y = cvtpk(v0[2] * bflo(b.y), v0[3] * bfhi(b.y));
                    w.z = cvtpk(v1[0] * bflo(b.z), v1[1] * bfhi(b.z)); w.w = cvtpk(v1[2] * bflo(b.w), v1[3] * bfhi(b.w));
                    *(u32x4*)(rowp + C_U + bj * HALF) = w;
                }
                if (m == 3) asm volatile("" ::: "memory");
            }
    }
};
struct EpiY {
    static constexpr bool PERM = true, AFTER_DRAIN = false; static constexpr int MID_T = 0;
    bf16_t* Y; float* rowss;
    __device__ __forceinline__ void operator()(const f32x4 (&acc)[2][2][4][2], const Unit& u, int wr, int wc, int fr, int fq) const {
        int row0 = u.pm * BM + wr * 64 + fr, col0 = u.pn * BM + wc * 32 + 8 * fq;
        asm volatile("" : "+v"(row0), "+v"(col0));
#pragma unroll
        for (int ai = 0; ai < 2; ++ai)
#pragma unroll
            for (int m = 0; m < 4; ++m) {
                const int row = row0 + ai * HALF + m * 16;
                bf16_t* rowp = Y + (size_t)row * KCAT + col0;
                float ss = 0.f;
#pragma unroll
                for (int bj = 0; bj < 2; ++bj) {
                    const f32x4 v0 = acc[ai][bj][m][0], v1 = acc[ai][bj][m][1];
                    ss += (v0[0] * v0[0] + v0[1] * v0[1]) + (v0[2] * v0[2] + v0[3] * v0[3]) + (v1[0] * v1[0] + v1[1] * v1[1]) + (v1[2] * v1[2] + v1[3] * v1[3]);
                    u32x4 w; w.x = cvtpk(v0[0], v0[1]); w.y = cvtpk(v0[2], v0[3]); w.z = cvtpk(v1[0], v1[1]); w.w = cvtpk(v1[2], v1[3]);
                    *(u32x4*)(rowp + bj * HALF) = w;
                }
                ss += __shfl_xor(ss, 16); ss += __shfl_xor(ss, 32);
                if (fq == 0) atomicAdd(rowss + row, ss);
            }
    }
};
}

__device__ __forceinline__ float wave_sum(float v) {
#pragma unroll
    for (int o = 1; o < 64; o <<= 1) v += __shfl_xor(v, o);
    return v;
}
__device__ __forceinline__ int win_dest_row(int n) {
    const bool rope = (n < C_VA) || (n >= C_QD && n < C_VD);
    if (!rope) return n;
    const int j = n & 63;
    return (n - j) + 2 * (j & 31) + (j >> 5);
}
template <bool PERMROWS>
__device__ __forceinline__ void transpose_item(const float* W, int N, bf16_t* WT, int ldk, int koff, LAS float* scr, int item, int lane) {
    const int nblk = N / 32, kb = item / nblk, nb = item % nblk, k0 = 64 * kb, n0 = 32 * nb;
#pragma unroll 8
    for (int i = 0; i < 32; ++i) { const int kk = 2 * i + (lane >> 5); scr[kk * 33 + (lane & 31)] = W[(size_t)(k0 + kk) * N + n0 + (lane & 31)]; }
    asm volatile("s_waitcnt lgkmcnt(0)" ::: "memory");
    const int c = lane & 7;
#pragma unroll
    for (int j = 0; j < 4; ++j) { const int n = (lane >> 3) + 8 * j; const LAS float* s = scr + (8 * c) * 33 + n;
        u32x4 o; o.x = cvtpk(s[0 * 33], s[1 * 33]); o.y = cvtpk(s[2 * 33], s[3 * 33]); o.z = cvtpk(s[4 * 33], s[5 * 33]); o.w = cvtpk(s[6 * 33], s[7 * 33]);
        const int dr = PERMROWS ? win_dest_row(n0 + n) : (n0 + n);
        *(u32x4*)(WT + (size_t)dr * ldk + koff + k0 + 8 * c) = o; }
    asm volatile("s_waitcnt lgkmcnt(0)" ::: "memory");
}
__device__ __forceinline__ void sincos_d(double a, float& s, float& c) {
    const double k = __builtin_rint(a * 0.63661977236758134308);
    const double r = __builtin_fma(-k, 6.123233995736766e-17, __builtin_fma(-k, 1.5707963267948966, a));
    const double r2 = r * r;
    double ps = -1.0 / 6227020800.0; ps = ps * r2 + 1.0 / 39916800.0; ps = ps * r2 - 1.0 / 362880.0; ps = ps * r2 + 1.0 / 5040.0; ps = ps * r2 - 1.0 / 120.0; ps = ps * r2 + 1.0 / 6.0; ps = -ps;
    const double sv = r + r * r2 * ps;
    double pc = 1.0 / 479001600.0; pc = pc * r2 - 1.0 / 3628800.0; pc = pc * r2 + 1.0 / 40320.0; pc = pc * r2 - 1.0 / 720.0; pc = pc * r2 + 1.0 / 24.0; pc = pc * r2 - 0.5;
    const double cv = 1.0 + r2 * pc;
    const int q = ((int)k) & 3;
    const double so = (q == 0) ? sv : (q == 1) ? cv : (q == 2) ? -sv : -cv;
    const double co = (q == 0) ? cv : (q == 1) ? -sv : (q == 2) ? -cv : sv;
    s = (float)so; c = (float)co;
}
struct Args { const void* in[16]; float* out; unsigned char* ws; int ph_lo, ph_hi; };
constexpr int N_PHASES = 2 + 5 * NCHUNK;

__device__ __forceinline__ void p0_prologue(const Args& a, LAS unsigned char* lds, int vcu, int G) {
    int tid_ = threadIdx.x; asm volatile("" : "+v"(tid_)); const int tid = tid_, lane = tid & 63, wave = __builtin_amdgcn_readfirstlane(tid >> 6);
    const float* c = (const float*)a.in[1]; const int* pos = (const int*)a.in[2];
    const float* w_ada = (const float*)a.in[3];
    const float* w_in = (const float*)a.in[6];
    const float* w_pa = (const float*)a.in[12]; const float* w_pb = (const float*)a.in[13]; const float* w_out = (const float*)a.in[14];
    unsigned char* ws = a.ws;
    {
        LAS float* sc = (LAS float*)lds;
        LAS float* red = (LAS float*)(lds + 16384);
        float* modp = (float*)(ws + WS_MODP);
        for (int it = vcu; it < 48 * 4; it += G) {
            const int cg_ = it >> 2, kq = it & 3, col = cg_ * 64 + lane;
            __syncthreads();
            for (int e = tid; e < 256 * 16; e += 512) { const int b = e >> 8, k = e & 255; sc[k * 16 + b] = siluf_(c[b * DM + kq * 256 + k]); }
            __syncthreads();
            float acc[16];
#pragma unroll
            for (int b = 0; b < 16; ++b) acc[b] = 0.f;
            const float* wp = w_ada + (size_t)(kq * 256 + wave * 32) * 3072 + col;
#pragma unroll 8
            for (int k = 0; k < 32; ++k) {
                const float w = wp[(size_t)k * 3072];
                const LAS f32x4* s4 = (const LAS f32x4*)(sc + (wave * 32 + k) * 16);
#pragma unroll
                for (int q = 0; q < 4; ++q) { const f32x4 s = s4[q]; acc[4 * q] += s[0] * w; acc[4 * q + 1] += s[1] * w; acc[4 * q + 2] += s[2] * w; acc[4 * q + 3] += s[3] * w; }
            }
#pragma unroll
            for (int b = 0; b < 16; ++b) red[(wave * 16 + b) * 64 + lane] = acc[b];
            __syncthreads();
            for (int e = tid; e < 16 * 64; e += 512) { const int b = e >> 6, cl = e & 63; float s = 0.f;
#pragma unroll
                for (int w = 0; w < 8; ++w) s += red[(w * 16 + b) * 64 + cl];
                modp[((size_t)kq * 16 + b) * 3072 + cg_ * 64 + cl] = s; }
        }
        __syncthreads();
    }
    {
        const int gt = vcu * 512 + tid, NGT = G * 512;
        float* rowss = (float*)(ws + WS_ROWSS);
        for (int e = gt; e < MTOT; e += NGT) rowss[e] = 0.f;
        if (vcu == 0 && wave == 0) {
            const float* q1 = (const float*)a.in[7]; const float* k1 = (const float*)a.in[8]; const float* q2 = (const float*)a.in[9]; const float* k2 = (const float*)a.in[10];
            const float s1 = wave_sum(q1[lane] * k1[lane]), s2 = wave_sum(q2[lane] * k2[lane]);
            if (lane == 0) *(float*)(ws + WS_LAM) = expf(s1) - expf(s2) + 0.2f;
        }
    }
}
__device__ __forceinline__ void p0b_weights(const Args& a, LAS unsigned char* lds, int vcu, int G) {
    int tid_ = threadIdx.x; asm volatile("" : "+v"(tid_)); const int tid = tid_, lane = tid & 63, wave = __builtin_amdgcn_readfirstlane(tid >> 6);
    const int* pos = (const int*)a.in[2];
    const float* w_in = (const float*)a.in[6];
    const float* w_pa = (const float*)a.in[12]; const float* w_pb = (const float*)a.in[13]; const float* w_out = (const float*)a.in[14];
    unsigned char* ws = a.ws;
    const int gw = vcu * NWAVES + wave, NGW = G * NWAVES;
    {
        LAS float* scr = (LAS float*)(lds + wave * 16384);
        constexpr int I_IN = (DM / 64) * (NIN / 32), I_A = (512 / 64) * (DM / 32), I_B = (DM / 64) * (DM / 32), I_O = I_B;
        bf16_t* WinT = (bf16_t*)(ws + WS_WIN); bf16_t* WcatT = (bf16_t*)(ws + WS_WCAT); bf16_t* WoutT = (bf16_t*)(ws + WS_WOUT);
        for (int it = gw; it < I_IN + I_A + I_B + I_O; it += NGW) {
            int r = it;
            if (r < I_IN) { transpose_item<true>(w_in, NIN, WinT, DM, 0, scr, r, lane); continue; } r -= I_IN;
            if (r < I_A) { transpose_item<false>(w_pa, DM, WcatT, KCAT, 0, scr, r, lane); continue; } r -= I_A;
            if (r < I_B) { transpose_item<false>(w_pb, DM, WcatT, KCAT, 512, scr, r, lane); continue; } r -= I_B;
            transpose_item<false>(w_out, DM, WoutT, DM, 0, scr, r, lane);
        }
    }
    {
        float* tab = (float*)(ws + WS_TAB);
        const int gt = vcu * 512 + tid, NGT = G * 512;
        for (int e = gt; e < MTOT * 32; e += NGT) {
            const int tok = e >> 5, f = e & 31;
            const float inv = exp2f(-(float)f * (13.287712379549449f / 32.0f));
            const float ang = (float)pos[tok] * inv;
            float s, cs; sincos_d((double)ang, s, cs);
            *(f32x2*)(tab + (size_t)e * 2) = (f32x2){cs, s};
        }
    }
}

__device__ __forceinline__ float mod_at(const float* modp, const float* b_ada, int b, int n) {
    float s = b_ada[n];
#pragma unroll
    for (int kq = 0; kq < 4; ++kq) s += modp[((size_t)kq * 16 + b) * 3072 + n];
    return s;
}
__device__ __forceinline__ void p1_h(const Args& a, int vcu, int G) {
    int tid_ = threadIdx.x; asm volatile("" : "+v"(tid_)); const int tid = tid_, lane = tid & 63, wave = __builtin_amdgcn_readfirstlane(tid >> 6);
    const float* x = (const float*)a.in[0]; const float* b_ada = (const float*)a.in[4]; const float* norm_pre = (const float*)a.in[5];
    const float* modp = (const float*)(a.ws + WS_MODP); bf16_t* H = (bf16_t*)(a.ws + WS_H);
    const int gw = vcu * NWAVES + wave, NGW = G * NWAVES;
    for (int grp = gw; grp < MTOT / 16; grp += NGW) {
        const int row0 = grp * 16, b = row0 / SEQ;
        f32x4 mul[4], add[4];
#pragma unroll
        for (int j = 0; j < 4; ++j)
#pragma unroll
            for (int e = 0; e < 4; ++e) { const int n = 256 * j + 4 * lane + e; mul[j][e] = norm_pre[n] * (1.0f + mod_at(modp, b_ada, b, 1024 + n)); add[j][e] = mod_at(modp, b_ada, b, n); }
        for (int rr = 0; rr < 16; ++rr) {
            const f32x4* xr = (const f32x4*)(x + (size_t)(row0 + rr) * DM) + lane;
            f32x4 v[4]; float s = 0.f;
#pragma unroll
            for (int j = 0; j < 4; ++j) { v[j] = xr[64 * j]; s += (v[j][0] * v[j][0] + v[j][1] * v[j][1]) + (v[j][2] * v[j][2] + v[j][3] * v[j][3]); }
            const float rstd = 1.0f / sqrtf(wave_sum(s) * (1.0f / DM) + EPS);
            u32x2* o8 = (u32x2*)(H + (size_t)(row0 + rr) * DM) + lane;
#pragma unroll
            for (int j = 0; j < 4; ++j) { const f32x4 y = v[j] * rstd * mul[j] + add[j]; o8[64 * j] = (u32x2){cvtpk(y[0], y[1]), cvtpk(y[2], y[3])}; }
        }
    }
}

__device__ __forceinline__ void p6_final(const Args& a, int chunk, int vcu, int G) {
    int tid_ = threadIdx.x; asm volatile("" : "+v"(tid_)); const int tid = tid_, lane = tid & 63, wave = __builtin_amdgcn_readfirstlane(tid >> 6);
    const float* x = (const float*)a.in[0]; const float* b_ada = (const float*)a.in[4]; const float* norm_post = (const float*)a.in[15];
    const float* modp = (const float*)(a.ws + WS_MODP); const float* rowss = (const float*)(a.ws + WS_ROWSS);
    const bf16_t* Y = (const bf16_t*)(a.ws + WS_ACAT);
    const int gw = vcu * NWAVES + wave, NGW = G * NWAVES;
    for (int grp = gw; grp < MC / 16; grp += NGW) {
        const int lrow0 = grp * 16, row0 = chunk * MC + lrow0, b = row0 / SEQ;
        f32x4 gmul[4];
#pragma unroll
        for (int j = 0; j < 4; ++j)
#pragma unroll
            for (int e = 0; e < 4; ++e) { const int n = 256 * j + 4 * lane + e; gmul[j][e] = norm_post[n] * mod_at(modp, b_ada, b, 2048 + n); }
        for (int rr = 0; rr < 16; ++rr) {
            const float rstd = 1.0f / sqrtf(rowss[row0 + rr] * (1.0f / DM) + EPS);
            const f32x4* xr = (const f32x4*)(x + (size_t)(row0 + rr) * DM) + lane;
            const u32x2* yr = (const u32x2*)(Y + (size_t)(lrow0 + rr) * KCAT) + lane;
            f32x4* orow = (f32x4*)(a.out + (size_t)(row0 + rr) * DM) + lane;
#pragma unroll
            for (int j = 0; j < 4; ++j) { const u32x2 yw = yr[64 * j]; const f32x4 y = {bflo(yw.x), bfhi(yw.x), bflo(yw.y), bfhi(yw.y)};
                orow[64 * j] = xr[64 * j] + y * rstd * gmul[j]; }
        }
    }
}
typedef short v4i16_t __attribute__((ext_vector_type(4)));
__device__ __forceinline__ s16x4 vtr(const LAS unsigned char* p) { return __builtin_bit_cast(s16x4, __builtin_amdgcn_ds_read_tr16_b64_v4i16((LAS v4i16_t*)p)); }
#define MFMA32(a, b, c) __builtin_amdgcn_mfma_f32_32x32x16_bf16((a), (b), (c), 0, 0, 0)
__device__ __forceinline__ int crow(int i, int hh) { return (i & 3) + 8 * (i >> 2) + 4 * hh; }
__device__ __forceinline__ bf16x8 pack8(const f32x16& x, int s) {
    u32x4 p; p.x = cvtpk(x[8 * s], x[8 * s + 1]); p.y = cvtpk(x[8 * s + 2], x[8 * s + 3]); p.z = cvtpk(x[8 * s + 4], x[8 * s + 5]); p.w = cvtpk(x[8 * s + 6], x[8 * s + 7]);
    return __builtin_bit_cast(bf16x8, p);
}
#define SBAR() __builtin_amdgcn_sched_barrier(0)
__device__ __forceinline__ float xmax32(float v) { auto rr = __builtin_amdgcn_permlane32_swap(__float_as_uint(v), __float_as_uint(v), false, false); return fmaxf(__uint_as_float(rr[0]), __uint_as_float(rr[1])); }
__device__ __forceinline__ float xsum32(float v) { auto rr = __builtin_amdgcn_permlane32_swap(__float_as_uint(v), __float_as_uint(v), false, false); return __uint_as_float(rr[0]) + __uint_as_float(rr[1]); }
__device__ __forceinline__ bf16x8 cat4(s16x4 lo, s16x4 hi) { return (bf16x8){lo[0], lo[1], lo[2], lo[3], hi[0], hi[1], hi[2], hi[3]}; }

__device__ __forceinline__ void dsw_task(LAS unsigned char* wl, bf16_t* P, float* lse, int bl, int g, int hd, int sres, int n, int lane) {
    const int r = lane & 31, hh = lane >> 5, dsh = 2 * g, L = SEQ >> dsh, hc = (g * 8 + hd) * 64, l0 = n * 32;
    const size_t rowbase = (size_t)bl * SEQ;
    const int tokq = ((l0 + r) << dsh) + sres;
    bf16_t* qrow = P + (rowbase + tokq) * NIN + C_QA + hc;
    bf16x8 qf[4];
#pragma unroll
    for (int s = 0; s < 4; ++s) qf[s] = *(const bf16x8*)(qrow + 16 * s + 8 * hh);
    u32x4 vreg[3][4];
#pragma unroll
    for (int kb = 0; kb < 3; ++kb)
#pragma unroll
        for (int pc = 0; pc < 4; ++pc) { int lk = l0 - 64 + 32 * kb + 16 * (pc & 1) + (lane >> 2); lk = lk < 0 ? 0 : (lk >= L ? L - 1 : lk);
            vreg[kb][pc] = *(const u32x4*)(P + (rowbase + ((lk << dsh) + sres)) * NIN + C_VA + hc + (pc >> 1) * 32 + (lane & 3) * 8); }
    f32x16 S[5];
#pragma unroll
    for (int kb = 0; kb < 5; ++kb) {
        int lk = l0 - 64 + 32 * kb + r; lk = lk < 0 ? 0 : (lk >= L ? L - 1 : lk);
        const bf16_t* krow = P + (rowbase + ((lk << dsh) + sres)) * NIN + C_KA + hc + 8 * hh;
        bf16x8 kf[4];
#pragma unroll
        for (int s = 0; s < 4; ++s) kf[s] = *(const bf16x8*)(krow + 16 * s);
        f32x16 acc = {};
#pragma unroll
        for (int s = 0; s < 4; ++s) acc = MFMA32(kf[s], qf[s], acc);
        S[kb] = acc;
    }
#pragma unroll
    for (int kb = 0; kb < 3; ++kb)
#pragma unroll
        for (int pc = 0; pc < 4; ++pc) *(LAS u32x4*)(wl + kb * 4096 + pc * 1024 + lane * 16) = vreg[kb][pc];
#pragma unroll
    for (int kb = 3; kb < 5; ++kb)
#pragma unroll
        for (int pc = 0; pc < 4; ++pc) { int lk = l0 - 64 + 32 * kb + 16 * (pc & 1) + (lane >> 2); lk = lk < 0 ? 0 : (lk >= L ? L - 1 : lk);
            vreg[kb - 3][pc] = *(const u32x4*)(P + (rowbase + ((lk << dsh) + sres)) * NIN + C_VA + hc + (pc >> 1) * 32 + (lane & 3) * 8); }
    const int lq = l0 + r;
    float mx = -1e30f;
#pragma unroll
    for (int kb = 0; kb < 5; ++kb)
#pragma unroll
        for (int i = 0; i < 16; ++i) { const int lk = l0 - 64 + 32 * kb + crow(i, hh); const int d = lk - lq;
            const bool valid = (lk >= 0) && (lk < L) && (d <= 64) && (d >= -64);
            const float v = valid ? S[kb][i] : -1e30f; S[kb][i] = v; mx = fmaxf(mx, v); }
    mx = fmaxf(mx, __shfl_xor(mx, 32));
    float sum = 0.f;
#pragma unroll
    for (int kb = 0; kb < 5; ++kb)
#pragma unroll
        for (int i = 0; i < 16; ++i) { const float p = fexp2(S[kb][i] - mx); S[kb][i] = p; sum += p; }
    sum += __shfl_xor(sum, 32);
    f32x16 O[2]; O[0] = (f32x16){}; O[1] = (f32x16){};
    const LAS unsigned char* vb = wl + ((lane >> 4) & 1) * 32 + (lane & 3) * 8 + (4 * hh + ((lane & 15) >> 2)) * 64;
#pragma unroll
    for (int kb = 0; kb < 5; ++kb) {
        if (kb == 3) {
#pragma unroll
            for (int k2 = 0; k2 < 2; ++k2)
#pragma unroll
                for (int pc = 0; pc < 4; ++pc) *(LAS u32x4*)(wl + k2 * 4096 + pc * 1024 + lane * 16) = vreg[k2][pc];
        }
        const int slot = kb < 3 ? kb : kb - 3;
#pragma unroll
        for (int ks = 0; ks < 2; ++ks) {
            const bf16x8 pf = pack8(S[kb], ks);
#pragma unroll
            for (int d = 0; d < 2; ++d) {
                const s16x4 lo = vtr(vb + slot * 4096 + d * 2048 + ks * 1024), hi = vtr(vb + slot * 4096 + d * 2048 + ks * 1024 + 512);
                O[d] = MFMA32(cat4(lo, hi), pf, O[d]);
            }
        }
    }
    const float inv = 1.0f / sum;
#pragma unroll
    for (int d = 0; d < 2; ++d)
#pragma unroll
        for (int gq = 0; gq < 4; ++gq) {
            const u32x2 w = {cvtpk(O[d][4 * gq] * inv, O[d][4 * gq + 1] * inv), cvtpk(O[d][4 * gq + 2] * inv, O[d][4 * gq + 3] * inv)};
            *(u32x2*)(qrow + 32 * d + 8 * gq + 4 * hh) = w;
        }
    if (hh == 0) lse[(rowbase + tokq) * 24 + g * 8 + hd] = mx + log2f(sum);
}
__device__ __forceinline__ void dsw_unit(LAS unsigned char* lds, bf16_t* P, float* lse, bf16_t* Acat, int bl, int hd, int rq) {
    int tid_ = threadIdx.x; asm volatile("" : "+v"(tid_)); const int tid = tid_, lane = tid & 63, wave = __builtin_amdgcn_readfirstlane(tid >> 6);
    LAS unsigned char* wl = lds + wave * 12288;
    const int t0 = rq * 512;
#pragma unroll 1
    for (int g = 0; g < 3; ++g) {
        const int dil = 1 << (2 * g);
#pragma unroll 1
        for (int jj = 0; jj < 2; ++jj) { const int j = wave + 8 * jj; dsw_task(wl, P, lse, bl, g, hd, j % dil, (t0 / (32 * dil)) + j / dil, lane); }
    }
    __syncthreads();
    const size_t rowbase = (size_t)bl * SEQ + t0;
#pragma unroll 1
    for (int it = 0; it < 8; ++it) {
        const size_t row = rowbase + (tid >> 3) + 64 * it; const int piece = tid & 7;
        const float* lp = lse + row * 24 + hd;
        const float l0 = lp[0], l1 = lp[8], l2 = lp[16], mx = fmaxf(l0, fmaxf(l1, l2));
        float a0 = fexp2(l0 - mx), a1 = fexp2(l1 - mx), a2 = fexp2(l2 - mx); const float inv = 1.0f / (a0 + a1 + a2); a0 *= inv; a1 *= inv; a2 *= inv;
        const bf16_t* pr = P + row * NIN;
        const u32x4 o0 = *(const u32x4*)(pr + C_QA + hd * 64 + piece * 8), o1 = *(const u32x4*)(pr + C_QA + (8 + hd) * 64 + piece * 8), o2 = *(const u32x4*)(pr + C_QA + (16 + hd) * 64 + piece * 8);
        const u32x4 z = *(const u32x4*)(pr + C_ZA + hd * 64 + piece * 8);
        u32x4 w;
#define MRG(f) w.f = cvtpk((a0 * bflo(o0.f) + a1 * bflo(o1.f) + a2 * bflo(o2.f)) * bflo(z.f), (a0 * bfhi(o0.f) + a1 * bfhi(o1.f) + a2 * bfhi(o2.f)) * bfhi(z.f))
        MRG(x); MRG(y); MRG(z); MRG(w);
#undef MRG
        *(u32x4*)(Acat + row * KCAT + hd * 64 + piece * 8) = w;
    }
    __syncthreads();
}

constexpr float DIFF_THR = 6.0f;
__device__ __forceinline__ void diff_unit(LAS unsigned char* lds, const bf16_t* P, bf16_t* Acat, const float* subln, float lam, int bl, int h, int qb) {
    int tid_ = threadIdx.x; asm volatile("" : "+v"(tid_)); const int tid = tid_, lane = tid & 63, wave = __builtin_amdgcn_readfirstlane(tid >> 6);
    const int r = lane & 31, hh = lane >> 5, c = wave & 1, qi = wave >> 1;
    const size_t rowbase = (size_t)bl * SEQ;
    const size_t qrowi = rowbase + qb * 128 + qi * 32 + r;
    bf16x8 qf[4];
    { const bf16_t* qp = P + qrowi * NIN + C_QD + h * 128 + c * 64 + hh * 8;
#pragma unroll
      for (int s = 0; s < 4; ++s) qf[s] = *(const bf16x8*)(qp + 16 * s); }
    const bf16_t* ksrc[2]; const bf16_t* vsrc[2]; int kdst[2], vdst[2];
#pragma unroll
    for (int i = 0; i < 2; ++i) {
        const int p = tid + 512 * i, key = p >> 4, part = p & 15;
        ksrc[i] = P + (rowbase + key) * NIN + C_KD + h * 128 + part * 8; kdst[i] = (part >> 3) * 8320 + (part & 7) * 1040 + key * 16;
        vsrc[i] = P + (rowbase + key) * NIN + C_VD + h * 128 + part * 8; vdst[i] = 16640 + (part >> 2) * 4160 + (key >> 4) * 1024 + (key & 15) * 64 + (part & 3) * 16;
    }
    u32x4 kr[2], vr[2];
#pragma unroll
    for (int i = 0; i < 2; ++i) { kr[i] = *(const u32x4*)ksrc[i]; vr[i] = *(const u32x4*)vsrc[i]; }
#pragma unroll
    for (int i = 0; i < 2; ++i) { *(LAS u32x4*)(lds + kdst[i]) = kr[i]; *(LAS u32x4*)(lds + vdst[i]) = vr[i]; }
    __syncthreads();
    f32x16 O[4];
#pragma unroll
    for (int d = 0; d < 4; ++d) O[d] = (f32x16){};
    float m = -1e30f, l = 0.f;
    const int kfo = c * 8320 + hh * 1040 + r * 16;
    const int vfo = 16640 + ((lane >> 4) & 1) * 32 + (lane & 3) * 8 + (4 * hh + ((lane & 15) >> 2)) * 64;
    constexpr int NT = SEQ / 64;
#pragma unroll 1
    for (int t = 0; t < NT; ++t) {
        const int buf = (t & 1) * 33792;
        if (t + 1 < NT) {
#pragma unroll
            for (int i = 0; i < 2; ++i) { kr[i] = *(const u32x4*)(ksrc[i] + (size_t)(t + 1) * 64 * NIN); vr[i] = *(const u32x4*)(vsrc[i] + (size_t)(t + 1) * 64 * NIN); }
        }
        f32x16 S0 = {}, S1 = {};
        { const LAS unsigned char* kb = lds + buf + kfo;
          bf16x8 kf[8];
#pragma unroll
          for (int s = 0; s < 4; ++s) { kf[2 * s] = *(const LAS bf16x8*)(kb + s * 2080); kf[2 * s + 1] = *(const LAS bf16x8*)(kb + s * 2080 + 512); }
          SBAR();
#pragma unroll
          for (int s = 0; s < 4; ++s) { S0 = MFMA32(kf[2 * s], qf[s], S0); S1 = MFMA32(kf[2 * s + 1], qf[s], S1); } }
        const LAS unsigned char* vb = lds + buf + vfo;
        s16x4 vlo[2][4], vhi[2][4];
#pragma unroll
        for (int d = 0; d < 4; ++d) { vlo[0][d] = vtr(vb + d * 4160); vhi[0][d] = vtr(vb + d * 4160 + 512); }
        SBAR();
        float mx = fmaxf(S0[0], S1[0]);
#pragma unroll
        for (int i = 1; i < 16; ++i) mx = fmaxf(mx, fmaxf(S0[i], S1[i]));
        mx = xmax32(mx);
        if (__any(mx > m + DIFF_THR)) {
            const float mn = fmaxf(m, mx), al = fexp2(m - mn);
            l *= al;
#pragma unroll
            for (int d = 0; d < 4; ++d) O[d] *= al;
            m = mn;
        }
        float ps = 0.f;
#pragma unroll
        for (int i = 0; i < 16; ++i) { S0[i] = fexp2(S0[i] - m); S1[i] = fexp2(S1[i] - m); ps += S0[i] + S1[i]; }
        l += ps;
        SBAR();
#pragma unroll
        for (int ks = 0; ks < 4; ++ks) {
            if (ks < 3) {
#pragma unroll
                for (int d = 0; d < 4; ++d) { vlo[(ks + 1) & 1][d] = vtr(vb + d * 4160 + (ks + 1) * 1024); vhi[(ks + 1) & 1][d] = vtr(vb + d * 4160 + (ks + 1) * 1024 + 512); }
            }
            const bf16x8 pf = (ks < 2) ? pack8(S0, ks & 1) : pack8(S1, ks & 1);
            SBAR();
#pragma unroll
            for (int d = 0; d < 4; ++d) O[d] = MFMA32(cat4(vlo[ks & 1][d], vhi[ks & 1][d]), pf, O[d]);
            SBAR();
        }
        if (t + 1 < NT) {
            const int nb = ((t + 1) & 1) * 33792;
#pragma unroll
            for (int i = 0; i < 2; ++i) { *(LAS u32x4*)(lds + nb + kdst[i]) = kr[i]; *(LAS u32x4*)(lds + nb + vdst[i]) = vr[i]; }
        }
        __syncthreads();
    }
    l = xsum32(l);
    LAS float* ex = (LAS float*)(lds + 69632) + qi * 4096 + lane;
    if (c == 1) {
        const float sc = lam / l;
#pragma unroll
        for (int d = 0; d < 4; ++d)
#pragma unroll
            for (int i = 0; i < 16; ++i) ex[(d * 16 + i) * 64] = O[d][i] * sc;
    }
    __syncthreads();
    if (c == 0) {
        const float inv = 1.0f / l; float ss = 0.f;
#pragma unroll
        for (int d = 0; d < 4; ++d)
#pragma unroll
            for (int i = 0; i < 16; ++i) { const float y = O[d][i] * inv - ex[(d * 16 + i) * 64]; O[d][i] = y; ss += y * y; }
        ss = xsum32(ss);
        const float rstd = 0.8f / sqrtf(ss * (1.0f / 128.0f) + EPS);
        const bf16_t* zrow = P + qrowi * NIN + C_ZD + h * 128; bf16_t* orow = Acat + qrowi * KCAT + 512 + h * 128;
#pragma unroll
        for (int d = 0; d < 4; ++d)
#pragma unroll
            for (int gq = 0; gq < 4; ++gq) { const int dim = 32 * d + 8 * gq + 4 * hh;
                const f32x4 w = *(const f32x4*)(subln + dim); const u32x2 z = *(const u32x2*)(zrow + dim);
                const u32x2 o = {cvtpk(O[d][4 * gq] * rstd * w[0] * bflo(z.x), O[d][4 * gq + 1] * rstd * w[1] * bfhi(z.x)), cvtpk(O[d][4 * gq + 2] * rstd * w[2] * bflo(z.y), O[d][4 * gq + 3] * rstd * w[3] * bfhi(z.y))};
                *(u32x2*)(orow + dim) = o; }
    }
    __syncthreads();
}
#define XB_TMO      128
#define XB_XCNT(j)  (256  + 64 * (j))
#define XB_XSUB(j)  (1280 + 64 * (j))
#define XB_XGEN(j)  (2304 + 64 * (j))
#define XB_TOP      3328
#define XB_TOPGEN   3392
#define XCD_BAR_WORDS 3456
#define XB_SPIN_CAP (1u << 18)

__device__ __forceinline__ unsigned xb_ld(unsigned* p)              { return __hip_atomic_load(p, __ATOMIC_RELAXED, __HIP_MEMORY_SCOPE_AGENT); }
__device__ __forceinline__ unsigned xb_add(unsigned* p, unsigned v) { return __hip_atomic_fetch_add(p, v, __ATOMIC_RELAXED, __HIP_MEMORY_SCOPE_AGENT); }
__device__ __forceinline__ unsigned xb_xcc_id() { return (unsigned)__builtin_amdgcn_s_getreg((3 << 11) | 20) & 0xFu; }
#define XB_SPIN(cond, bar) do { unsigned _sp = 0; while (cond) { __builtin_amdgcn_s_sleep(1); \
    if ((++_sp & 255u) == 0u) { if (xb_ld(&(bar)[XB_TMO])) break; if (_sp > XB_SPIN_CAP) { atomicAdd(&(bar)[XB_TMO], 1u); break; } } } } while (0)

struct XcdBarrier {
    unsigned* bar; unsigned x;
    volatile LAS unsigned* st;
};

__device__ __forceinline__ XcdBarrier xcd_barrier_post(unsigned* bar, volatile LAS unsigned* st) {
    XcdBarrier b; b.bar = bar; b.x = xb_xcc_id(); b.st = st;
    if (threadIdx.x == 0) (void)xb_add(&bar[XB_XCNT(b.x)], 1u);
    return b;
}
__device__ __forceinline__ void xcd_barrier_complete(unsigned* bar, unsigned x, unsigned& nloc, unsigned& nx) {
    const unsigned G = gridDim.x * gridDim.y * gridDim.z;
    unsigned sum, cnt, mine, sp = 0u;
    for (;;) {
        sum = 0u; cnt = 0u; mine = 0u;
#pragma unroll
        for (unsigned j = 0; j < 16; ++j) { const unsigned c = xb_ld(&bar[XB_XCNT(j)]); sum += c; cnt += (c > 0u) ? 1u : 0u; mine = (j == x) ? c : mine; }
        if (sum == G) break;
        __builtin_amdgcn_s_sleep(1);
        if ((++sp & 255u) == 0u) { if (xb_ld(&bar[XB_TMO])) break; if (sp > XB_SPIN_CAP) { atomicAdd(&bar[XB_TMO], 1u); break; } }
    }
    nloc = mine > 0u ? mine : 1u; nx = cnt > 0u ? cnt : 1u;
}

__device__ __forceinline__ void xcd_barrier(const XcdBarrier& b) {
    asm volatile("s_waitcnt vmcnt(0)" ::: "memory");
    __syncthreads();
    if (threadIdx.x == 0) {
        unsigned* bar = b.bar;
        __builtin_amdgcn_s_waitcnt(0);
        unsigned nloc = b.st[0], nx = b.st[1];
        if (nloc == 0u) { xcd_barrier_complete(bar, b.x, nloc, nx); b.st[0] = nloc; b.st[1] = nx; }
        const unsigned old = xb_add(&bar[XB_XSUB(b.x)], 1u);
        const unsigned gen = old / nloc;
        if (old + 1u == (gen + 1u) * nloc) {
            __builtin_amdgcn_fence(__ATOMIC_RELEASE, "agent");
            asm volatile("s_waitcnt vmcnt(0)" ::: "memory");
            const unsigned og = xb_add(&bar[XB_TOP], 1u);
            const unsigned tg = og / nx;
            if (og + 1u == (tg + 1u) * nx) xb_add(&bar[XB_TOPGEN], 1u);
            else XB_SPIN(xb_ld(&bar[XB_TOPGEN]) == tg, bar);
            __builtin_amdgcn_fence(__ATOMIC_ACQUIRE, "agent");
            xb_add(&bar[XB_XGEN(b.x)], 1u);
            asm volatile("s_waitcnt vmcnt(0)" ::: "memory");
        } else {
            XB_SPIN(xb_ld(&bar[XB_XGEN(b.x)]) == gen, bar);
            __builtin_amdgcn_fence(__ATOMIC_ACQUIRE, "agent");
            asm volatile("s_waitcnt vmcnt(0)" ::: "memory");
        }
    }
    __syncthreads();
}

#ifndef REP_SYNC
#define REP_SYNC 1
#endif
__global__ void __launch_bounds__(NWAVES * 64, 2) hybrid_fwd(Args args) {
    extern __shared__ __attribute__((aligned(16))) unsigned char lds_raw[];
    LAS unsigned char* lds = (LAS unsigned char*)lds_raw;
    cg::grid_group grid = cg::this_grid();
    const int G = gridDim.x, bx = blockIdx.x;
    const int vcu = (G % 8 == 0) ? (bx % 8) * (G / 8) + bx / 8 : bx;
    unsigned char* ws = args.ws;
    unsigned* barw = (unsigned*)(ws + WS_BAR);
    XcdBarrier xbar; xbar.bar = barw; xbar.x = 0; xbar.st = (volatile LAS unsigned*)(lds + LDS_BYTES - 64);
    if (threadIdx.x < 16) ((volatile LAS unsigned*)(lds + LDS_BYTES - 64))[threadIdx.x] = 0u;
    if (bx == 0) { for (int i = threadIdx.x; i < XCD_BAR_WORDS; i += NWAVES * 64) barw[i] = 0u; }
    __syncthreads();
#define SEAM() do { for (int rs_ = 0; rs_ < REP_SYNC; ++rs_) xcd_barrier(xbar); } while (0)
    p0_prologue(args, lds, vcu, G);
    grid.sync();
    xbar = xcd_barrier_post(barw, (volatile LAS unsigned*)(lds + LDS_BYTES - 64));
    p1_h(args, vcu, G);
    p0b_weights(args, lds, vcu, G);
    SEAM();
    bf16_t* P = (bf16_t*)(ws + WS_PROJ); bf16_t* Acat = (bf16_t*)(ws + WS_ACAT); float* lse = (float*)(ws + WS_LSE);
#pragma unroll 1
    for (int ch = 0; ch < NCHUNK; ++ch) {
        if (ch > 0) p6_final(args, ch - 1, vcu, G);
        {
            typedef pg8::Gemm<MC, NIN, DM, DM, DM> GT; typedef pg8::StaticOrder<MC, NIN> SO;
            GT g{(const bf16_t*)(ws + WS_H) + (size_t)ch * MC * DM, (const bf16_t*)(ws + WS_WIN)};
            SO S; S.init(G, bx);
            pg8::EpiIn E{P, (const float*)(ws + WS_TAB) + (size_t)ch * MC * 64};
            pg8::gemm_phase<pg8::EpiIn, SO, GT, true, true>(lds, g, S, E);
        }
        SEAM();
        {
            for (int u = vcu; u < BPC * 8 * 4; u += G) dsw_unit(lds, P, lse, Acat, u >> 5, (u >> 2) & 7, u & 3);
            const float lam = *(const float*)(ws + WS_LAM); const float* subln = (const float*)args.in[11];
            for (int u = vcu; u < BPC * 8 * 16; u += G) diff_unit(lds, P, Acat, subln, lam, u >> 7, (u >> 4) & 7, u & 15);
        }
        SEAM();
        {
            typedef pg8::Gemm<MC, DM, KCAT, KCAT, KCAT> GT; typedef pg8::StaticOrder<MC, DM> SO;
            GT g{Acat, (const bf16_t*)(ws + WS_WCAT)};
            SO S; S.init(G, bx);
            pg8::EpiU E{P};
            pg8::gemm_phase<pg8::EpiU, SO, GT, true, true>(lds, g, S, E);
        }
        SEAM();
        {
            typedef pg8::Gemm<MC, DM, DM, NIN, DM> GT; typedef pg8::StaticOrder<MC, DM> SO;
            GT g{P + C_U, (const bf16_t*)(ws + WS_WOUT)};
            SO S; S.init(G, bx);
            pg8::EpiY E{Acat, (float*)(ws + WS_ROWSS) + (size_t)ch * MC};
            pg8::gemm_phase<pg8::EpiY, SO, GT, true, true>(lds, g, S, E);
        }
        SEAM();
    }
    p6_final(args, NCHUNK - 1, vcu, G);
#undef SEAM
}

extern "C" void kernel_launch(void* const* d_in, const int* in_sizes, int n_in, void* d_out, int out_size, void* d_ws, size_t ws_size, hipStream_t stream) {
    static int grid = 0;
    if (grid == 0) {
        if (n_in != 16 || out_size != MTOT * DM || ws_size < WS_END) { fprintf(stderr, "kernel_launch: unexpected shapes: n_in %d out %d ws %zu (need %zu)\n", n_in, out_size, ws_size, (size_t)WS_END); grid = -1; return; }
        int dev = 0, cus = 0, per_cu = 0;
        hipGetDevice(&dev); hipDeviceGetAttribute(&cus, hipDeviceAttributeMultiprocessorCount, dev);
        if (hipFuncSetAttribute((const void*)hybrid_fwd, hipFuncAttributeMaxDynamicSharedMemorySize, LDS_BYTES) != hipSuccess) { fprintf(stderr, "kernel_launch: hipFuncSetAttribute failed\n"); grid = -1; return; }
        hipOccupancyMaxActiveBlocksPerMultiprocessor(&per_cu, (const void*)hybrid_fwd, NWAVES * 64, LDS_BYTES);
        (void)hipGetLastError();
        if (per_cu < 1) { fprintf(stderr, "kernel_launch: occupancy query says %d blocks per CU\n", per_cu); per_cu = 1; }
        grid = cus;
        fprintf(stderr, "kernel_launch: cus %d per_cu %d grid %d ws %zu\n", cus, per_cu, grid, ws_size);
    }
    if (grid < 0) return;
    Args a{};
    for (int i = 0; i < 16; ++i) a.in[i] = d_in[i];
    a.out = (float*)d_out; a.ws = (unsigned char*)d_ws;
    a.ph_lo = 0; a.ph_hi = 0;
    void* kargs[] = {&a};
    hipError_t e = hipLaunchCooperativeKernel((const void*)hybrid_fwd, dim3(grid), dim3(NWAVES * 64), kargs, LDS_BYTES, stream);
    if (e != hipSuccess) fprintf(stderr, "kernel_launch: cooperative launch failed: %s (grid %d)\n", hipGetErrorString(e), grid);
}
```

```cpp
#include <hip/hip_runtime.h>
#include <hip/hip_cooperative_groups.h>
#include <cstdio>
#include <cstdint>
namespace cg = cooperative_groups;

constexpr int DM = 1024, NBATCH = 16, SEQ = 2048, MTOT = NBATCH * SEQ;
constexpr int NCHUNK = 2, MC = MTOT / NCHUNK, BPC = NBATCH / NCHUNK;
constexpr int NIN = 11264;
constexpr int NP = 9216;
constexpr int C_QA = 0, C_KA = 1536, C_VA = 3072, C_ZA = 4608, C_QD = 5120, C_ZD = 6144, C_GA = 7168, C_GB = 8192;
constexpr int C_U = 0, C_Y = 1536;
constexpr int KCAT = 1536;
constexpr float QSCALE = 0.125f * 1.4426950408889634f;
constexpr float EPS = 1e-6f;
constexpr size_t MiB = 1u << 20;
constexpr size_t WS_MODP = 0;
constexpr size_t WS_LAM = 800 * 1024;
constexpr size_t WS_ROWSS = 832 * 1024;
constexpr size_t WS_BAR = 960 * 1024;
constexpr size_t WS_TAB = 1 * MiB;
constexpr size_t WS_WIN = 9 * MiB;
constexpr size_t WS_WCAT = 31 * MiB;
constexpr size_t WS_WOUT = 34 * MiB;
constexpr size_t WS_LSE = 36 * MiB;
constexpr size_t WS_H = 38 * MiB;
constexpr size_t WS_ACAT = 102 * MiB;
constexpr size_t WS_PROJ = 150 * MiB;
constexpr size_t WS_KVD = 438 * MiB;
constexpr size_t WS_END = 502 * MiB;
constexpr int LDS_BYTES = 147456;
constexpr int NWAVES = 8;

#define LAS __attribute__((address_space(3)))
typedef unsigned short bf16_t;
typedef short bf16x8 __attribute__((ext_vector_type(8)));
typedef short s16x4 __attribute__((ext_vector_type(4)));
typedef float f32x4 __attribute__((ext_vector_type(4)));
typedef float f32x2 __attribute__((ext_vector_type(2)));
typedef float f32x16 __attribute__((ext_vector_type(16)));
typedef unsigned u32x4 __attribute__((ext_vector_type(4)));
typedef unsigned u32x2 __attribute__((ext_vector_type(2)));
typedef __bf16 bf16x2_t __attribute__((ext_vector_type(2)));
__device__ __forceinline__ unsigned cvtpk(float lo, float hi) { f32x2 v = {lo, hi}; bf16x2_t b = __builtin_convertvector(v, bf16x2_t); return __builtin_bit_cast(unsigned, b); }
__device__ __forceinline__ float bflo(unsigned w) { return __uint_as_float(w << 16); }
__device__ __forceinline__ float bfhi(unsigned w) { return __uint_as_float(w & 0xffff0000u); }
__device__ __forceinline__ float fexp2(float x) { return __builtin_amdgcn_exp2f(x); }
__device__ __forceinline__ float frcp(float x) { return __builtin_amdgcn_rcpf(x); }
__device__ __forceinline__ float sigmoidf_(float v) { return frcp(1.0f + fexp2(-1.4426950408889634f * v)); }
__device__ __forceinline__ float siluf_(float v) { return v * sigmoidf_(v); }

namespace pg8 {
#define PG8_LAS __attribute__((address_space(3)))
constexpr int BM = 256, BK = 64, HALF = 128, HTB = HALF * BK * 2  , STAGE_BYTES = 8 * HTB, NXCD = 8, WGM = 8;

__host__ __device__ __forceinline__ int lds_byte(int r, int c) { const int st = (r >> 4) * 2 + (c >> 5), rr = r & 15, cc = c & 31, ob = rr * 64 + cc * 2; return st * 1024 + (ob ^ (((ob >> 9) & 1) << 5)); }
__host__ __device__ __forceinline__ void stage_rc(int b, int& R, int& C) { const int st = b / 1024, sb = b % 1024, swz = sb ^ (((sb >> 9) & 1) << 5); R = (st >> 1) * 16 + swz / 64; C = (st & 1) * 32 + (swz % 64) / 2; }
__host__ __device__ __forceinline__ int perm32(int rho) { const int n = rho >> 4, i = rho & 15; return 8 * (i >> 2) + 4 * n + (i & 3); }

struct Unit { int pm, pn; };
template <int M_, int N_, int K_, int LDA_, int LDB_> struct Gemm { const bf16_t* A; const bf16_t* Bt; static constexpr int M = M_, N = N_, K = K_, lda = LDA_, ldb = LDB_; };

template <int M_, int N_> struct StaticOrder {
    static constexpr int nM = M_ / BM, nN = N_ / BM, nwg = nM * nN;
    int G, c;
    __host__ __device__ void init(int G_, int c_) { G = G_; c = c_; }
    __host__ __device__ bool next(int i, Unit& u) const {
        const int L = i * G + c; if (L >= nwg) return false;
        int wgid = L; { constexpr int q = nwg / NXCD, r = nwg % NXCD; const int xcd = wgid % NXCD, off = wgid / NXCD; wgid = (xcd < r ? xcd * (q + 1) : r * (q + 1) + (xcd - r) * q) + off; }
        constexpr int nig = WGM * nN; const int gid = wgid / nig, fm = gid * WGM, gsz = (nM - fm) < WGM ? (nM - fm) : WGM;
        u.pm = fm + ((wgid % nig) % gsz); u.pn = (wgid % nig) / gsz; return true;
    }
    __device__ __forceinline__ void a_ready(const Unit&) const {}
    __device__ __forceinline__ void done(const Unit&) const {}
};


template <class Epi, class Sched, class GemmT, bool ALIGN_EPI = false, bool SP2 = false>
__device__ __forceinline__ void gemm_phase(PG8_LAS unsigned char* lds, const GemmT g, const Sched& S, const Epi& E) {
    int tid_ = threadIdx.x; asm volatile("" : "+v"(tid_));
    const int tid = tid_, wid = __builtin_amdgcn_readfirstlane(tid >> 6), lane = tid & 63, wr = wid >> 2, wc = wid & 3, fr = lane & 15, fq = lane >> 4;
    constexpr int K = GemmT::K, nt = K / BK;
    unsigned voffA[2], voffB[2];
#pragma unroll
    for (int i = 0; i < 2; ++i) { int R, C; stage_rc(tid * 16 + i * 8192, R, C); const int Rb = Epi::PERM ? ((R & ~31) + perm32(R & 31)) : R;
        voffA[i] = (unsigned)(R * GemmT::lda + C) * 2u; voffB[i] = (unsigned)(Rb * GemmT::ldb + C) * 2u; }
    constexpr size_t kstep = (size_t)(BK * 2);
    constexpr size_t hstepA = (size_t)HALF * GemmT::lda * 2, hstepB = (size_t)HALF * GemmT::ldb * 2;
    constexpr size_t tstepA = 2 * hstepA, tstepB = 2 * hstepB;
    const unsigned ldsw = (unsigned)wid * 1024u;
    const int aoff = lds_byte(wr * 64 + fr, fq * 8), boff = lds_byte(wc * 32 + fr, fq * 8);
#define PG8_SA(b, h) (((b) * 2 + (h)) * HTB)
#define PG8_SB(b, h) ((4 + (b) * 2 + (h)) * HTB)
#define PG8_STAGE(bufoff, gbase, voff) do { _Pragma("unroll") for (int _i = 0; _i < 2; ++_i) \
        __builtin_amdgcn_global_load_lds((const unsigned*)((const char*)(gbase) + (voff)[_i]), (PG8_LAS unsigned*)(lds + (bufoff) + ldsw + _i * 8192), 16, 0, 0); } while (0)
#define PG8_LDA(dst, b, h) do { _Pragma("unroll") for (int m = 0; m < 4; ++m) _Pragma("unroll") for (int k = 0; k < 2; ++k) dst[m][k] = *(const PG8_LAS bf16x8*)(lds + PG8_SA(b, h) + aoff + m * 2048 + k * 1024); } while (0)
#define PG8_LDB(dst, b, h) do { _Pragma("unroll") for (int n = 0; n < 2; ++n) _Pragma("unroll") for (int k = 0; k < 2; ++k) dst[n][k] = *(const PG8_LAS bf16x8*)(lds + PG8_SB(b, h) + boff + n * 2048 + k * 1024); } while (0)
#define PG8_MMA(ai, bj, At, Bt) do { __builtin_amdgcn_s_setprio(1); _Pragma("unroll") for (int m = 0; m < 4; ++m) _Pragma("unroll") for (int n = 0; n < 2; ++n) _Pragma("unroll") for (int k = 0; k < 2; ++k) \
        acc[ai][bj][m][n] = __builtin_amdgcn_mfma_f32_16x16x32_bf16(Bt[n][k], At[m][k], acc[ai][bj][m][n], 0, 0, 0); __builtin_amdgcn_s_setprio(0); } while (0)
#define PG8_WAIT_V(n) asm volatile("s_waitcnt vmcnt(" #n ")" ::: "memory")
#define PG8_WAIT_L(n) asm volatile("s_waitcnt lgkmcnt(" #n ")" ::: "memory")
#define PG8_BAR __builtin_amdgcn_s_barrier()
#define PG8_SCHED __builtin_amdgcn_sched_barrier(0)
    Unit cur, nxt; int ui = 0;
    if (!S.next(0, cur)) return;
    f32x4 acc[2][2][4][2];
#pragma unroll
    for (int a = 0; a < 2; ++a)
#pragma unroll
        for (int b = 0; b < 2; ++b)
#pragma unroll
            for (int m = 0; m < 4; ++m)
#pragma unroll
                for (int n = 0; n < 2; ++n) acc[a][b][m][n] = (f32x4){0.f, 0.f, 0.f, 0.f};
    bf16x8 At[4][2], B0[2][2], B1[2][2];
    const char* cA = (const char*)g.A + (size_t)cur.pm * tstepA; const char* cB = (const char*)g.Bt + (size_t)cur.pn * tstepB;
    S.a_ready(cur);
    if constexpr (SP2) {
        PG8_STAGE(PG8_SB(0, 0), cB, voffB); PG8_STAGE(PG8_SB(0, 1), cB + hstepB, voffB); PG8_STAGE(PG8_SA(0, 0), cA, voffA); PG8_STAGE(PG8_SA(0, 1), cA + hstepA, voffA);
        if (wr == 1) PG8_BAR;
        PG8_WAIT_V(2); PG8_BAR;
        PG8_STAGE(PG8_SB(1, 0), cB + kstep, voffB); PG8_STAGE(PG8_SA(1, 0), cA + kstep, voffA); PG8_STAGE(PG8_SB(1, 1), cB + hstepB + kstep, voffB);
        PG8_WAIT_V(6); PG8_BAR;
    } else {
        PG8_STAGE(PG8_SB(0, 0), cB, voffB); PG8_STAGE(PG8_SA(0, 0), cA, voffA); PG8_STAGE(PG8_SB(0, 1), cB + hstepB, voffB); PG8_STAGE(PG8_SA(0, 1), cA + hstepA, voffA);
        if (wr == 1) PG8_BAR;
        PG8_WAIT_V(4); PG8_BAR;
        PG8_STAGE(PG8_SB(1, 0), cB + kstep, voffB); PG8_STAGE(PG8_SA(1, 0), cA + kstep, voffA); PG8_STAGE(PG8_SB(1, 1), cB + hstepB + kstep, voffB);
        PG8_WAIT_V(6); PG8_BAR;
    }
    for (;;) {
        const bool has_next = S.next(ui + 1, nxt);
        const char* nA = has_next ? (const char*)g.A + (size_t)nxt.pm * tstepA : cA; const char* nB = has_next ? (const char*)g.Bt + (size_t)nxt.pn * tstepB : cB;
        constexpr int NSEG = (Epi::MID_T > 0) ? 2 : 1;
#pragma unroll 1
        for (int seg = 0; seg < NSEG; ++seg) {
        const int t_beg = (seg == 0) ? 0 : Epi::MID_T, t_end = (NSEG == 2 && seg == 0) ? Epi::MID_T : nt;
#pragma unroll 1
        for (int t = t_beg; t < t_end; t += 2) {
            const bool last = (t == nt - 2);
            const char* a1 = cA + (size_t)(t + 1) * kstep;
            const char* a2 = last ? nA : cA + (size_t)(t + 2) * kstep; const char* b2 = last ? nB : cB + (size_t)(t + 2) * kstep;
            const char* a3 = a2 + kstep; const char* b3 = b2 + kstep;
            if (last && has_next) S.a_ready(nxt);
            if constexpr (SP2) {
            PG8_LDB(B0, 0, 0); PG8_LDB(B1, 0, 1); PG8_SCHED; PG8_LDA(At, 0, 0); PG8_STAGE(PG8_SA(1, 1), a1 + hstepA, voffA);
            PG8_WAIT_V(8); PG8_WAIT_L(0); PG8_BAR; PG8_MMA(0, 0, At, B0); PG8_MMA(0, 1, At, B1); PG8_BAR; PG8_SCHED;
            PG8_LDA(At, 0, 1); PG8_STAGE(PG8_SB(0, 0), b2, voffB); PG8_STAGE(PG8_SB(0, 1), b2 + hstepB, voffB); PG8_STAGE(PG8_SA(0, 0), a2, voffA);
            PG8_WAIT_V(8); PG8_WAIT_L(0); PG8_BAR; PG8_MMA(1, 0, At, B0); PG8_MMA(1, 1, At, B1); PG8_BAR; PG8_SCHED;
            PG8_LDB(B0, 1, 0); PG8_LDB(B1, 1, 1); PG8_SCHED; PG8_LDA(At, 1, 0); PG8_STAGE(PG8_SA(0, 1), a2 + hstepA, voffA);
            PG8_WAIT_V(8); PG8_WAIT_L(0); PG8_BAR; PG8_MMA(0, 0, At, B0); PG8_MMA(0, 1, At, B1); PG8_BAR; PG8_SCHED;
            PG8_LDA(At, 1, 1); PG8_STAGE(PG8_SB(1, 0), b3, voffB); PG8_STAGE(PG8_SB(1, 1), b3 + hstepB, voffB); PG8_STAGE(PG8_SA(1, 0), a3, voffA);
            PG8_WAIT_V(8); PG8_WAIT_L(0); PG8_BAR; PG8_MMA(1, 0, At, B0); PG8_MMA(1, 1, At, B1); PG8_BAR; PG8_SCHED;
            } else {
            PG8_LDB(B0, 0, 0); PG8_SCHED; PG8_LDA(At, 0, 0); PG8_STAGE(PG8_SA(1, 1), a1 + hstepA, voffA);
            PG8_WAIT_L(8); PG8_BAR; PG8_WAIT_L(0); PG8_MMA(0, 0, At, B0); PG8_BAR; PG8_SCHED;
            PG8_LDB(B1, 0, 1); PG8_STAGE(PG8_SB(0, 0), b2, voffB);
            PG8_BAR; PG8_WAIT_L(0); PG8_MMA(0, 1, At, B1); PG8_BAR;
            PG8_LDA(At, 0, 1); PG8_STAGE(PG8_SA(0, 0), a2, voffA);
            PG8_BAR; PG8_WAIT_L(0); PG8_MMA(1, 0, At, B0); PG8_BAR; PG8_SCHED;
            PG8_STAGE(PG8_SB(0, 1), b2 + hstepB, voffB);
            PG8_WAIT_V(6); PG8_BAR; PG8_MMA(1, 1, At, B1); PG8_BAR;
            PG8_LDB(B0, 1, 0); PG8_SCHED; PG8_LDA(At, 1, 0); PG8_STAGE(PG8_SA(0, 1), a2 + hstepA, voffA);
            PG8_WAIT_L(8); PG8_BAR; PG8_WAIT_L(0); PG8_MMA(0, 0, At, B0); PG8_BAR; PG8_SCHED;
            PG8_LDB(B1, 1, 1); PG8_STAGE(PG8_SB(1, 0), b3, voffB);
            PG8_BAR; PG8_WAIT_L(0); PG8_MMA(0, 1, At, B1); PG8_BAR;
            PG8_LDA(At, 1, 1); PG8_STAGE(PG8_SA(1, 0), a3, voffA);
            PG8_BAR; PG8_WAIT_L(0); PG8_MMA(1, 0, At, B0); PG8_BAR; PG8_SCHED;
            PG8_STAGE(PG8_SB(1, 1), b3 + hstepB, voffB);
            PG8_WAIT_V(6); PG8_BAR; PG8_MMA(1, 1, At, B1); PG8_BAR;
            }
        }
        if constexpr (NSEG == 2) { if (seg == 0) E.mid(acc, cur, wr, wc, fr, fq); }
        }
        if constexpr (ALIGN_EPI) { if (wr == 0) PG8_BAR; }
        if constexpr (!Epi::AFTER_DRAIN) { E(acc, cur, wr, wc, fr, fq);
#ifdef REP_EPI
            if constexpr (Epi::REP2) { asm volatile("" ::: "memory"); E(acc, cur, wr, wc, fr, fq); }
#endif
            S.done(cur); }
        if (!has_next) break;
#pragma unroll
        for (int a = 0; a < 2; ++a)
#pragma unroll
            for (int b = 0; b < 2; ++b)
#pragma unroll
                for (int m = 0; m < 4; ++m)
#pragma unroll
                    for (int n = 0; n < 2; ++n) acc[a][b][m][n] = (f32x4){0.f, 0.f, 0.f, 0.f};
        cur = nxt; cA = nA; cB = nB; ++ui;
        if constexpr (ALIGN_EPI) { if (wr == 1) PG8_BAR; }
    }
    PG8_WAIT_V(0);
    if constexpr (!ALIGN_EPI) { if (wr == 0) PG8_BAR; }
    PG8_BAR;
    if constexpr (Epi::AFTER_DRAIN) { E.fused(acc, cur, wr, wc, fr, fq, lds, wid, lane); S.done(cur); }
#undef PG8_SA
#undef PG8_SB
#undef PG8_STAGE
#undef PG8_LDA
#undef PG8_LDB
#undef PG8_MMA
#undef PG8_WAIT_V
#undef PG8_WAIT_L
#undef PG8_BAR
#undef PG8_SCHED
}
}

namespace pg8 {
struct EpiIn {
    static constexpr bool PERM = true, AFTER_DRAIN = false, REP2 = true; static constexpr int MID_T = 0;
    bf16_t* P; bf16_t* KVD; const int* pos;
    __device__ __forceinline__ void operator()(const f32x4 (&acc)[2][2][4][2], const Unit& u, int wr, int wc, int fr, int fq) const {
        const int pn = u.pn;
        int mode;
        if (pn < 6) mode = 1; else if (pn < 12) mode = 2; else if (pn < 18) mode = 0; else if (pn < 20) mode = 3; else if (pn < 24) mode = 1;
        else if (pn < 28) mode = 2; else if (pn < 32) mode = 0; else if (pn < 36) mode = 3; else mode = 4;
        int row0 = u.pm * BM + wr * 64 + fr, col0 = pn * BM + wc * 32 + 8 * fq;
        asm volatile("" : "+v"(row0), "+v"(col0));
        float posf[8], ifr[2][4]; const float sc = (mode == 1) ? QSCALE : 1.0f;
        if (mode == 1 || mode == 2) {
#pragma unroll
            for (int i = 0; i < 8; ++i) posf[i] = (float)pos[row0 + (i >> 2) * HALF + (i & 3) * 16];
#pragma unroll
            for (int bj = 0; bj < 2; ++bj)
#pragma unroll
                for (int e2 = 0; e2 < 4; ++e2) { const int f = (((col0 + bj * HALF) & 63) >> 1) + e2; ifr[bj][e2] = fexp2(-(float)f * (13.287712379549449f / 32.0f)) * 0.15915494309189535f; }
        }
#pragma unroll
        for (int ai = 0; ai < 2; ++ai)
#pragma unroll
            for (int m = 0; m < 4; ++m) {
                const int row = row0 + ai * HALF + m * 16;
                bf16_t* rowp; size_t bjstep;
                if (pn >= 24 && pn < 32) { const int isv = pn >= 28, hp = pn - (isv ? 28 : 24);
                    rowp = KVD + ((size_t)((row >> 11) * 8 + hp * 2) * SEQ + (row & (SEQ - 1))) * 256 + isv * 128 + wc * 32 + 8 * fq; bjstep = (size_t)SEQ * 256; }
                else { rowp = P + (size_t)row * NP + (col0 - (pn >= 32 ? 2048 : 0)); bjstep = HALF; }
#pragma unroll
                for (int bj = 0; bj < 2; ++bj) {
                    f32x4 v0 = acc[ai][bj][m][0], v1 = acc[ai][bj][m][1];
                    if (mode == 1 || mode == 2) {
                        float cs[4], sn[4];
#pragma unroll
                        for (int e2 = 0; e2 < 4; ++e2) { const float rev = __builtin_amdgcn_fractf(posf[ai * 4 + m] * ifr[bj][e2]); cs[e2] = __builtin_amdgcn_cosf(rev) * sc; sn[e2] = __builtin_amdgcn_sinf(rev) * sc; }
                        f32x4 o0, o1;
                        o0[0] = v0[0] * cs[0] - v0[1] * sn[0]; o0[1] = v0[1] * cs[0] + v0[0] * sn[0];
                        o0[2] = v0[2] * cs[1] - v0[3] * sn[1]; o0[3] = v0[3] * cs[1] + v0[2] * sn[1];
                        o1[0] = v1[0] * cs[2] - v1[1] * sn[2]; o1[1] = v1[1] * cs[2] + v1[0] * sn[2];
                        o1[2] = v1[2] * cs[3] - v1[3] * sn[3]; o1[3] = v1[3] * cs[3] + v1[2] * sn[3];
                        v0 = o0; v1 = o1;
                    } else if (mode == 3) {
#pragma unroll
                        for (int e = 0; e < 4; ++e) { v0[e] = siluf_(v0[e]); v1[e] = siluf_(v1[e]); }
                    } else if (mode == 4) {
#pragma unroll
                        for (int e = 0; e < 4; ++e) { v0[e] = sigmoidf_(v0[e]); v1[e] = sigmoidf_(v1[e]); }
                    }
                    u32x4 w; w.x = cvtpk(v0[0], v0[1]); w.y = cvtpk(v0[2], v0[3]); w.z = cvtpk(v1[0], v1[1]); w.w = cvtpk(v1[2], v1[3]);
                    *(u32x4*)(rowp + bj * bjstep) = w;
                }
            }
    }
};
struct EpiU {
    static constexpr bool PERM = true, AFTER_DRAIN = false, REP2 = false; static constexpr int MID_T = 8;
    bf16_t* P;
    __device__ __forceinline__ void mid(f32x4 (&acc)[2][2][4][2], const Unit& u, int wr, int wc, int fr, int fq) const {
        int row0 = u.pm * BM + wr * 64 + fr, col0 = u.pn * BM + wc * 32 + 8 * fq;
        asm volatile("" : "+v"(row0), "+v"(col0));
#pragma unroll
        for (int ai = 0; ai < 2; ++ai)
#pragma unroll
            for (int m = 0; m < 4; ++m) {
                const bf16_t* rowp = P + (size_t)(row0 + ai * HALF + m * 16) * NP + col0;
#pragma unroll
                for (int bj = 0; bj < 2; ++bj) {
                    const u32x4 a = *(const u32x4*)(rowp + C_GA + bj * HALF), b = *(const u32x4*)(rowp + C_GB + bj * HALF);
                    f32x4 r0, r1;
                    r0[0] = bflo(a.x) * frcp(bflo(b.x)); r0[1] = bfhi(a.x) * frcp(bfhi(b.x)); r0[2] = bflo(a.y) * frcp(bflo(b.y)); r0[3] = bfhi(a.y) * frcp(bfhi(b.y));
                    r1[0] = bflo(a.z) * frcp(bflo(b.z)); r1[1] = bfhi(a.z) * frcp(bfhi(b.z)); r1[2] = bflo(a.w) * frcp(bflo(b.w)); r1[3] = bfhi(a.w) * frcp(bfhi(b.w));
                    acc[ai][bj][m][0] *= r0; acc[ai][bj][m][1] *= r1;
                }
                if (m == 3) asm volatile("" ::: "memory");
            }
    }
    __device__ __forceinline__ void operator()(const f32x4 (&acc)[2][2][4][2], const Unit& u, int wr, int wc, int fr, int fq) const {
        int row0 = u.pm * BM + wr * 64 + fr, col0 = u.pn * BM + wc * 32 + 8 * fq;
        asm volatile("" : "+v"(row0), "+v"(col0));
#pragma unroll
        for (int ai = 0; ai < 2; ++ai)
#pragma unroll
            for (int m = 0; m < 4; ++m) {
                bf16_t* rowp = P + (size_t)(row0 + ai * HALF + m * 16) * NP + col0;
#pragma unroll
                for (int bj = 0; bj < 2; ++bj) {
                    const u32x4 b = *(const u32x4*)(rowp + C_GB + bj * HALF);
                    const f32x4 v0 = acc[ai][bj][m][0], v1 = acc[ai][bj][m][1];
                    u32x4 w; w.x = cvtpk(v0[0] * bflo(b.x), v0[1] * bfhi(b.x)); w.y = cvtpk(v0[2] * bflo(b.y), v0[3] * bfhi(b.y));
                    w.z = cvtpk(v1[0] * bflo(b.z), v1[1] * bfhi(b.z)); w.w = cvtpk(v1[2] * bflo(b.w), v1[3] * bfhi(b.w));
                    *(u32x4*)(rowp + C_U + bj * HALF) = w;
                }
                if (m == 3) asm volatile("" ::: "memory");
            }
    }
};
struct EpiY {
    static constexpr bool PERM = true, AFTER_DRAIN = false, REP2 = false; static constexpr int MID_T = 0;
    bf16_t* Y; float* rowss;
    __device__ __forceinline__ void operator()(const f32x4 (&acc)[2][2][4][2], const Unit& u, int wr, int wc, int fr, int fq) const {
        int row0 = u.pm * BM + wr * 64 + fr, col0 = u.pn * BM + wc * 32 + 8 * fq;
        asm volatile("" : "+v"(row0), "+v"(col0));
#pragma unroll
        for (int ai = 0; ai < 2; ++ai)
#pragma unroll
            for (int m = 0; m < 4; ++m) {
                const int row = row0 + ai * HALF + m * 16;
                bf16_t* rowp = Y + (size_t)row * KCAT + col0;
                float ss = 0.f;
#pragma unroll
                for (int bj = 0; bj < 2; ++bj) {
                    const f32x4 v0 = acc[ai][bj][m][0], v1 = acc[ai][bj][m][1];
                    ss += (v0[0] * v0[0] + v0[1] * v0[1]) + (v0[2] * v0[2] + v0[3] * v0[3]) + (v1[0] * v1[0] + v1[1] * v1[1]) + (v1[2] * v1[2] + v1[3] * v1[3]);
                    u32x4 w; w.x = cvtpk(v0[0], v0[1]); w.y = cvtpk(v0[2], v0[3]); w.z = cvtpk(v1[0], v1[1]); w.w = cvtpk(v1[2], v1[3]);
                    *(u32x4*)(rowp + bj * HALF) = w;
                }
                ss += __shfl_xor(ss, 16); ss += __shfl_xor(ss, 32);
                if (fq == 0) atomicAdd(rowss + row, ss);
            }
    }
};
}

__device__ __forceinline__ float wave_sum(float v) {
#pragma unroll
    for (int o = 1; o < 64; o <<= 1) v += __shfl_xor(v, o);
    return v;
}
__device__ __forceinline__ int win_dest_row(int n) {
    const bool rope = (n < 3072) || (n >= 5120 && n < 7168);
    if (!rope) return n;
    const int j = n & 63;
    return (n - j) + 2 * (j & 31) + (j >> 5);
}
template <bool PERMROWS>
__device__ __forceinline__ void transpose_item(const float* W, int N, bf16_t* WT, int ldk, int koff, LAS float* scr, int item, int lane) {
    const int nblk = N / 32, kb = item / nblk, nb = item % nblk, k0 = 64 * kb, n0 = 32 * nb;
#pragma unroll 8
    for (int i = 0; i < 32; ++i) { const int kk = 2 * i + (lane >> 5); scr[kk * 33 + (lane & 31)] = W[(size_t)(k0 + kk) * N + n0 + (lane & 31)]; }
    asm volatile("s_waitcnt lgkmcnt(0)" ::: "memory");
    const int c = lane & 7;
#pragma unroll
    for (int j = 0; j < 4; ++j) { const int n = (lane >> 3) + 8 * j; const LAS float* s = scr + (8 * c) * 33 + n;
        u32x4 o; o.x = cvtpk(s[0 * 33], s[1 * 33]); o.y = cvtpk(s[2 * 33], s[3 * 33]); o.z = cvtpk(s[4 * 33], s[5 * 33]); o.w = cvtpk(s[6 * 33], s[7 * 33]);
        const int dr = PERMROWS ? win_dest_row(n0 + n) : (n0 + n);
        *(u32x4*)(WT + (size_t)dr * ldk + koff + k0 + 8 * c) = o; }
    asm volatile("s_waitcnt lgkmcnt(0)" ::: "memory");
}
__device__ __forceinline__ void sincos_d(double a, float& s, float& c) {
    const double k = __builtin_rint(a * 0.63661977236758134308);
    const double r = __builtin_fma(-k, 6.123233995736766e-17, __builtin_fma(-k, 1.5707963267948966, a));
    const double r2 = r * r;
    double ps = -1.0 / 6227020800.0; ps = ps * r2 + 1.0 / 39916800.0; ps = ps * r2 - 1.0 / 362880.0; ps = ps * r2 + 1.0 / 5040.0; ps = ps * r2 - 1.0 / 120.0; ps = ps * r2 + 1.0 / 6.0; ps = -ps;
    const double sv = r + r * r2 * ps;
    double pc = 1.0 / 479001600.0; pc = pc * r2 - 1.0 / 3628800.0; pc = pc * r2 + 1.0 / 40320.0; pc = pc * r2 - 1.0 / 720.0; pc = pc * r2 + 1.0 / 24.0; pc = pc * r2 - 0.5;
    const double cv = 1.0 + r2 * pc;
    const int q = ((int)k) & 3;
    const double so = (q == 0) ? sv : (q == 1) ? cv : (q == 2) ? -sv : -cv;
    const double co = (q == 0) ? cv : (q == 1) ? -sv : (q == 2) ? -cv : sv;
    s = (float)so; c = (float)co;
}
struct Args { const void* in[16]; float* out; unsigned char* ws; int ph_lo, ph_hi; };
constexpr int N_PHASES = 2 + 5 * NCHUNK;

__device__ __forceinline__ void p0_prologue(const Args& a, LAS unsigned char* lds, int vcu, int G) {
    int tid_ = threadIdx.x; asm volatile("" : "+v"(tid_)); const int tid = tid_, lane = tid & 63, wave = __builtin_amdgcn_readfirstlane(tid >> 6);
    const float* c = (const float*)a.in[1]; const int* pos = (const int*)a.in[2];
    const float* w_ada = (const float*)a.in[3];
    const float* w_in = (const float*)a.in[6];
    const float* w_pa = (const float*)a.in[12]; const float* w_pb = (const float*)a.in[13]; const float* w_out = (const float*)a.in[14];
    unsigned char* ws = a.ws;
    {
        LAS float* sc = (LAS float*)lds;
        LAS float* red = (LAS float*)(lds + 16384);
        float* modp = (float*)(ws + WS_MODP);
        for (int it = vcu; it < 48 * 4; it += G) {
            const int cg_ = it >> 2, kq = it & 3, col = cg_ * 64 + lane;
            __syncthreads();
            for (int e = tid; e < 256 * 16; e += 512) { const int b = e >> 8, k = e & 255; sc[k * 16 + b] = siluf_(c[b * DM + kq * 256 + k]); }
            __syncthreads();
            float acc[16];
#pragma unroll
            for (int b = 0; b < 16; ++b) acc[b] = 0.f;
            const float* wp = w_ada + (size_t)(kq * 256 + wave * 32) * 3072 + col;
#pragma unroll 8
            for (int k = 0; k < 32; ++k) {
                const float w = wp[(size_t)k * 3072];
                const LAS f32x4* s4 = (const LAS f32x4*)(sc + (wave * 32 + k) * 16);
#pragma unroll
                for (int q = 0; q < 4; ++q) { const f32x4 s = s4[q]; acc[4 * q] += s[0] * w; acc[4 * q + 1] += s[1] * w; acc[4 * q + 2] += s[2] * w; acc[4 * q + 3] += s[3] * w; }
            }
#pragma unroll
            for (int b = 0; b < 16; ++b) red[(wave * 16 + b) * 64 + lane] = acc[b];
            __syncthreads();
            for (int e = tid; e < 16 * 64; e += 512) { const int b = e >> 6, cl = e & 63; float s = 0.f;
#pragma unroll
                for (int w = 0; w < 8; ++w) s += red[(w * 16 + b) * 64 + cl];
                modp[((size_t)kq * 16 + b) * 3072 + cg_ * 64 + cl] = s; }
        }
        __syncthreads();
    }
    {
        const int gt = vcu * 512 + tid, NGT = G * 512;
        float* rowss = (float*)(ws + WS_ROWSS);
        for (int e = gt; e < MTOT; e += NGT) rowss[e] = 0.f;
        if (vcu == 0 && wave == 0) {
            const float* q1 = (const float*)a.in[7]; const float* k1 = (const float*)a.in[8]; const float* q2 = (const float*)a.in[9]; const float* k2 = (const float*)a.in[10];
            const float s1 = wave_sum(q1[lane] * k1[lane]), s2 = wave_sum(q2[lane] * k2[lane]);
            if (lane == 0) *(float*)(ws + WS_LAM) = expf(s1) - expf(s2) + 0.2f;
        }
    }
}
__device__ __forceinline__ void p0b_weights(const Args& a, LAS unsigned char* lds, int vcu, int G) {
    int tid_ = threadIdx.x; asm volatile("" : "+v"(tid_)); const int tid = tid_, lane = tid & 63, wave = __builtin_amdgcn_readfirstlane(tid >> 6);
    const float* w_in = (const float*)a.in[6];
    const float* w_pa = (const float*)a.in[12]; const float* w_pb = (const float*)a.in[13]; const float* w_out = (const float*)a.in[14];
    unsigned char* ws = a.ws;
    const int gw = vcu * NWAVES + wave, NGW = G * NWAVES;
    {
        LAS float* scr = (LAS float*)(lds + wave * 16384);
        constexpr int I_IN = (DM / 64) * (NIN / 32), I_A = (512 / 64) * (DM / 32), I_B = (DM / 64) * (DM / 32), I_O = I_B;
        bf16_t* WinT = (bf16_t*)(ws + WS_WIN); bf16_t* WcatT = (bf16_t*)(ws + WS_WCAT); bf16_t* WoutT = (bf16_t*)(ws + WS_WOUT);
        for (int it = gw; it < I_IN + I_A + I_B + I_O; it += NGW) {
            int r = it;
            if (r < I_IN) { transpose_item<true>(w_in, NIN, WinT, DM, 0, scr, r, lane); continue; } r -= I_IN;
            if (r < I_A) { transpose_item<false>(w_pa, DM, WcatT, KCAT, 0, scr, r, lane); continue; } r -= I_A;
            if (r < I_B) { transpose_item<false>(w_pb, DM, WcatT, KCAT, 512, scr, r, lane); continue; } r -= I_B;
            transpose_item<false>(w_out, DM, WoutT, DM, 0, scr, r, lane);
        }
    }
}

__device__ __forceinline__ float mod_at(const float* modp, const float* b_ada, int b, int n) {
    float s = b_ada[n];
#pragma unroll
    for (int kq = 0; kq < 4; ++kq) s += modp[((size_t)kq * 16 + b) * 3072 + n];
    return s;
}
__device__ __forceinline__ void p1_h(const Args& a, int vcu, int G) {
    int tid_ = threadIdx.x; asm volatile("" : "+v"(tid_)); const int tid = tid_, lane = tid & 63, wave = __builtin_amdgcn_readfirstlane(tid >> 6);
    const float* x = (const float*)a.in[0]; const float* b_ada = (const float*)a.in[4]; const float* norm_pre = (const float*)a.in[5];
    const float* modp = (const float*)(a.ws + WS_MODP); bf16_t* H = (bf16_t*)(a.ws + WS_H);
    const int gw = vcu * NWAVES + wave, NGW = G * NWAVES;
    for (int grp = gw; grp < MTOT / 16; grp += NGW) {
        const int row0 = grp * 16, b = row0 / SEQ;
        f32x4 mul[4], add[4];
#pragma unroll
        for (int j = 0; j < 4; ++j)
#pragma unroll
            for (int e = 0; e < 4; ++e) { const int n = 256 * j + 4 * lane + e; mul[j][e] = norm_pre[n] * (1.0f + mod_at(modp, b_ada, b, 1024 + n)); add[j][e] = mod_at(modp, b_ada, b, n); }
        for (int rr = 0; rr < 16; ++rr) {
            const f32x4* xr = (const f32x4*)(x + (size_t)(row0 + rr) * DM) + lane;
            f32x4 v[4]; float s = 0.f;
#pragma unroll
            for (int j = 0; j < 4; ++j) { v[j] = xr[64 * j]; s += (v[j][0] * v[j][0] + v[j][1] * v[j][1]) + (v[j][2] * v[j][2] + v[j][3] * v[j][3]); }
            const float rstd = 1.0f / sqrtf(wave_sum(s) * (1.0f / DM) + EPS);
            u32x2* o8 = (u32x2*)(H + (size_t)(row0 + rr) * DM) + lane;
#pragma unroll
            for (int j = 0; j < 4; ++j) { const f32x4 y = v[j] * rstd * mul[j] + add[j]; o8[64 * j] = (u32x2){cvtpk(y[0], y[1]), cvtpk(y[2], y[3])}; }
        }
    }
}

__device__ __forceinline__ void p6_final(const Args& a, int chunk, int vcu, int G) {
    int tid_ = threadIdx.x; asm volatile("" : "+v"(tid_)); const int tid = tid_, lane = tid & 63, wave = __builtin_amdgcn_readfirstlane(tid >> 6);
    const float* x = (const float*)a.in[0]; const float* b_ada = (const float*)a.in[4]; const float* norm_post = (const float*)a.in[15];
    const float* modp = (const float*)(a.ws + WS_MODP); const float* rowss = (const float*)(a.ws + WS_ROWSS);
    const bf16_t* Y = (const bf16_t*)(a.ws + WS_ACAT);
    const int gw = vcu * NWAVES + wave, NGW = G * NWAVES;
    for (int grp = gw; grp < MC / 16; grp += NGW) {
        const int lrow0 = grp * 16, row0 = chunk * MC + lrow0, b = row0 / SEQ;
        f32x4 gmul[4];
#pragma unroll
        for (int j = 0; j < 4; ++j)
#pragma unroll
            for (int e = 0; e < 4; ++e) { const int n = 256 * j + 4 * lane + e; gmul[j][e] = norm_post[n] * mod_at(modp, b_ada, b, 2048 + n); }
        for (int rr = 0; rr < 16; ++rr) {
            const float rstd = 1.0f / sqrtf(rowss[row0 + rr] * (1.0f / DM) + EPS);
            const f32x4* xr = (const f32x4*)(x + (size_t)(row0 + rr) * DM) + lane;
            const u32x2* yr = (const u32x2*)(Y + (size_t)(lrow0 + rr) * KCAT) + lane;
            f32x4* orow = (f32x4*)(a.out + (size_t)(row0 + rr) * DM) + lane;
#pragma unroll
            for (int j = 0; j < 4; ++j) { const u32x2 yw = yr[64 * j]; const f32x4 y = {bflo(yw.x), bfhi(yw.x), bflo(yw.y), bfhi(yw.y)};
                orow[64 * j] = xr[64 * j] + y * rstd * gmul[j]; }
        }
    }
}
typedef short v4i16_t __attribute__((ext_vector_type(4)));
__device__ __forceinline__ s16x4 vtr(const LAS unsigned char* p) { return __builtin_bit_cast(s16x4, __builtin_amdgcn_ds_read_tr16_b64_v4i16((LAS v4i16_t*)p)); }
#define MFMA32(a, b, c) __builtin_amdgcn_mfma_f32_32x32x16_bf16((a), (b), (c), 0, 0, 0)
__device__ __forceinline__ int crow(int i, int hh) { return (i & 3) + 8 * (i >> 2) + 4 * hh; }
__device__ __forceinline__ bf16x8 pack8(const f32x16& x, int s) {
    u32x4 p; p.x = cvtpk(x[8 * s], x[8 * s + 1]); p.y = cvtpk(x[8 * s + 2], x[8 * s + 3]); p.z = cvtpk(x[8 * s + 4], x[8 * s + 5]); p.w = cvtpk(x[8 * s + 6], x[8 * s + 7]);
    return __builtin_bit_cast(bf16x8, p);
}
#define SBAR() __builtin_amdgcn_sched_barrier(0)
__device__ __forceinline__ float xmax32(float v) { auto rr = __builtin_amdgcn_permlane32_swap(__float_as_uint(v), __float_as_uint(v), false, false); return fmaxf(__uint_as_float(rr[0]), __uint_as_float(rr[1])); }
__device__ __forceinline__ float xsum32(float v) { auto rr = __builtin_amdgcn_permlane32_swap(__float_as_uint(v), __float_as_uint(v), false, false); return __uint_as_float(rr[0]) + __uint_as_float(rr[1]); }
__device__ __forceinline__ bf16x8 cat4(s16x4 lo, s16x4 hi) { return (bf16x8){lo[0], lo[1], lo[2], lo[3], hi[0], hi[1], hi[2], hi[3]}; }

__device__ __forceinline__ void dsw_task(LAS unsigned char* wl, bf16_t* P, float* lse, int bl, int g, int hd, int sres, int n, int lane) {
    const int r = lane & 31, hh = lane >> 5, dsh = 2 * g, L = SEQ >> dsh, hc = (g * 8 + hd) * 64, l0 = n * 32;
    const size_t rowbase = (size_t)bl * SEQ;
    const int tokq = ((l0 + r) << dsh) + sres;
    bf16_t* qrow = P + (rowbase + tokq) * NP + C_QA + hc;
    bf16x8 qf[4];
#pragma unroll
    for (int s = 0; s < 4; ++s) qf[s] = *(const bf16x8*)(qrow + 16 * s + 8 * hh);
    u32x4 vreg[3][4];
#pragma unroll
    for (int kb = 0; kb < 3; ++kb)
#pragma unroll
        for (int pc = 0; pc < 4; ++pc) { int lk = l0 - 64 + 32 * kb + 16 * (pc & 1) + (lane >> 2); lk = lk < 0 ? 0 : (lk >= L ? L - 1 : lk);
            vreg[kb][pc] = *(const u32x4*)(P + (rowbase + ((lk << dsh) + sres)) * NP + C_VA + hc + (pc >> 1) * 32 + (lane & 3) * 8); }
    f32x16 S[5];
#pragma unroll
    for (int kb = 0; kb < 5; ++kb) {
        int lk = l0 - 64 + 32 * kb + r; lk = lk < 0 ? 0 : (lk >= L ? L - 1 : lk);
        const bf16_t* krow = P + (rowbase + ((lk << dsh) + sres)) * NP + C_KA + hc + 8 * hh;
        bf16x8 kf[4];
#pragma unroll
        for (int s = 0; s < 4; ++s) kf[s] = *(const bf16x8*)(krow + 16 * s);
        f32x16 acc = {};
#pragma unroll
        for (int s = 0; s < 4; ++s) acc = MFMA32(kf[s], qf[s], acc);
        S[kb] = acc;
    }
#pragma unroll
    for (int kb = 0; kb < 3; ++kb)
#pragma unroll
        for (int pc = 0; pc < 4; ++pc) *(LAS u32x4*)(wl + kb * 4096 + pc * 1024 + lane * 16) = vreg[kb][pc];
#pragma unroll
    for (int kb = 3; kb < 5; ++kb)
#pragma unroll
        for (int pc = 0; pc < 4; ++pc) { int lk = l0 - 64 + 32 * kb + 16 * (pc & 1) + (lane >> 2); lk = lk < 0 ? 0 : (lk >= L ? L - 1 : lk);
            vreg[kb - 3][pc] = *(const u32x4*)(P + (rowbase + ((lk << dsh) + sres)) * NP + C_VA + hc + (pc >> 1) * 32 + (lane & 3) * 8); }
    const int lq = l0 + r;
    float mx = -1e30f;
#pragma unroll
    for (int kb = 0; kb < 5; ++kb)
#pragma unroll
        for (int i = 0; i < 16; ++i) { const int lk = l0 - 64 + 32 * kb + crow(i, hh); const int d = lk - lq;
            const bool valid = (lk >= 0) && (lk < L) && (d <= 64) && (d >= -64);
            const float v = valid ? S[kb][i] : -1e30f; S[kb][i] = v; mx = fmaxf(mx, v); }
    mx = fmaxf(mx, __shfl_xor(mx, 32));
    float sum = 0.f;
#pragma unroll
    for (int kb = 0; kb < 5; ++kb)
#pragma unroll
        for (int i = 0; i < 16; ++i) { const float p = fexp2(S[kb][i] - mx); S[kb][i] = p; sum += p; }
    sum += __shfl_xor(sum, 32);
    f32x16 O[2]; O[0] = (f32x16){}; O[1] = (f32x16){};
    const LAS unsigned char* vb = wl + ((lane >> 4) & 1) * 32 + (lane & 3) * 8 + (4 * hh + ((lane & 15) >> 2)) * 64;
#pragma unroll
    for (int kb = 0; kb < 5; ++kb) {
        if (kb == 3) {
#pragma unroll
            for (int k2 = 0; k2 < 2; ++k2)
#pragma unroll
                for (int pc = 0; pc < 4; ++pc) *(LAS u32x4*)(wl + k2 * 4096 + pc * 1024 + lane * 16) = vreg[k2][pc];
        }
        const int slot = kb < 3 ? kb : kb - 3;
#pragma unroll
        for (int ks = 0; ks < 2; ++ks) {
            const bf16x8 pf = pack8(S[kb], ks);
#pragma unroll
            for (int d = 0; d < 2; ++d) {
                const s16x4 lo = vtr(vb + slot * 4096 + d * 2048 + ks * 1024), hi = vtr(vb + slot * 4096 + d * 2048 + ks * 1024 + 512);
                O[d] = MFMA32(cat4(lo, hi), pf, O[d]);
            }
        }
    }
    const float inv = 1.0f / sum;
#pragma unroll
    for (int d = 0; d < 2; ++d)
#pragma unroll
        for (int gq = 0; gq < 4; ++gq) {
            const u32x2 w = {cvtpk(O[d][4 * gq] * inv, O[d][4 * gq + 1] * inv), cvtpk(O[d][4 * gq + 2] * inv, O[d][4 * gq + 3] * inv)};
            *(u32x2*)(qrow + 32 * d + 8 * gq + 4 * hh) = w;
        }
    if (hh == 0) lse[(rowbase + tokq) * 24 + g * 8 + hd] = mx + log2f(sum);
}
__device__ __forceinline__ void dsw_unit(LAS unsigned char* lds, bf16_t* P, float* lse, bf16_t* Acat, int bl, int hd, int rq) {
    int tid_ = threadIdx.x; asm volatile("" : "+v"(tid_)); const int tid = tid_, lane = tid & 63, wave = __builtin_amdgcn_readfirstlane(tid >> 6);
    LAS unsigned char* wl = lds + wave * 12288;
    const int t0 = rq * 512;
#pragma unroll 1
    for (int g = 0; g < 3; ++g) {
        const int dil = 1 << (2 * g);
#pragma unroll 1
        for (int jj = 0; jj < 2; ++jj) { const int j = wave + 8 * jj; dsw_task(wl, P, lse, bl, g, hd, j % dil, (t0 / (32 * dil)) + j / dil, lane); }
    }
    __syncthreads();
    const size_t rowbase = (size_t)bl * SEQ + t0;
#pragma unroll 1
    for (int it = 0; it < 8; ++it) {
        const size_t row = rowbase + (tid >> 3) + 64 * it; const int piece = tid & 7;
        const float* lp = lse + row * 24 + hd;
        const float l0 = lp[0], l1 = lp[8], l2 = lp[16], mx = fmaxf(l0, fmaxf(l1, l2));
        float a0 = fexp2(l0 - mx), a1 = fexp2(l1 - mx), a2 = fexp2(l2 - mx); const float inv = 1.0f / (a0 + a1 + a2); a0 *= inv; a1 *= inv; a2 *= inv;
        const bf16_t* pr = P + row * NP;
        const u32x4 o0 = *(const u32x4*)(pr + C_QA + hd * 64 + piece * 8), o1 = *(const u32x4*)(pr + C_QA + (8 + hd) * 64 + piece * 8), o2 = *(const u32x4*)(pr + C_QA + (16 + hd) * 64 + piece * 8);
        const u32x4 z = *(const u32x4*)(pr + C_ZA + hd * 64 + piece * 8);
        u32x4 w;
#define MRG(f) w.f = cvtpk((a0 * bflo(o0.f) + a1 * bflo(o1.f) + a2 * bflo(o2.f)) * bflo(z.f), (a0 * bfhi(o0.f) + a1 * bfhi(o1.f) + a2 * bfhi(o2.f)) * bfhi(z.f))
        MRG(x); MRG(y); MRG(z); MRG(w);
#undef MRG
        *(u32x4*)(Acat + row * KCAT + hd * 64 + piece * 8) = w;
    }
    __syncthreads();
}

constexpr float DIFF_THR = 6.0f;
__device__ __forceinline__ void diff_unit(LAS unsigned char* lds, const bf16_t* P, const bf16_t* KVD, bf16_t* Acat, const float* subln, float lam, int bl, int h, int qb) {
    int tid_ = threadIdx.x; asm volatile("" : "+v"(tid_)); const int tid = tid_, lane = tid & 63, wave = __builtin_amdgcn_readfirstlane(tid >> 6);
    const int r = lane & 31, hh = lane >> 5, c = wave & 1, qi = wave >> 1;
    const size_t rowbase = (size_t)bl * SEQ;
    const size_t qrowi = rowbase + qb * 128 + qi * 32 + r;
    bf16x8 qf[4];
    { const bf16_t* qp = P + qrowi * NP + C_QD + h * 128 + c * 64 + hh * 8;
#pragma unroll
      for (int s = 0; s < 4; ++s) qf[s] = *(const bf16x8*)(qp + 16 * s); }
    const bf16_t* ksrc[2]; const bf16_t* vsrc[2]; int kdst[2], vdst[2];
#pragma unroll
    for (int i = 0; i < 2; ++i) {
        const int p = tid + 512 * i, key = p >> 4, part = p & 15;
        ksrc[i] = KVD + ((size_t)(bl * 8 + h) * SEQ + key) * 256 + part * 8; kdst[i] = (part >> 3) * 8320 + (part & 7) * 1040 + key * 16;
        vsrc[i] = KVD + ((size_t)(bl * 8 + h) * SEQ + key) * 256 + 128 + part * 8; vdst[i] = 16640 + (part >> 2) * 4160 + (key >> 4) * 1024 + (key & 15) * 64 + (part & 3) * 16;
    }
    u32x4 kr[2], vr[2];
#pragma unroll
    for (int i = 0; i < 2; ++i) { kr[i] = *(const u32x4*)ksrc[i]; vr[i] = *(const u32x4*)vsrc[i]; }
#pragma unroll
    for (int i = 0; i < 2; ++i) { *(LAS u32x4*)(lds + kdst[i]) = kr[i]; *(LAS u32x4*)(lds + vdst[i]) = vr[i]; }
    __syncthreads();
    f32x16 O[4];
#pragma unroll
    for (int d = 0; d < 4; ++d) O[d] = (f32x16){};
    float m = -1e30f, l = 0.f;
    const int kfo = c * 8320 + hh * 1040 + r * 16;
    const int vfo = 16640 + ((lane >> 4) & 1) * 32 + (lane & 3) * 8 + (4 * hh + ((lane & 15) >> 2)) * 64;
    constexpr int NT = SEQ / 64;
#pragma unroll 1
    for (int t = 0; t < NT; ++t) {
        const int buf = (t & 1) * 33792;
        if (t + 1 < NT) {
#pragma unroll
            for (int i = 0; i < 2; ++i) { kr[i] = *(const u32x4*)(ksrc[i] + (size_t)(t + 1) * 64 * 256); vr[i] = *(const u32x4*)(vsrc[i] + (size_t)(t + 1) * 64 * 256); }
        }
        f32x16 S0 = {}, S1 = {};
        { const LAS unsigned char* kb = lds + buf + kfo;
          bf16x8 kf[8];
#pragma unroll
          for (int s = 0; s < 4; ++s) { kf[2 * s] = *(const LAS bf16x8*)(kb + s * 2080); kf[2 * s + 1] = *(const LAS bf16x8*)(kb + s * 2080 + 512); }
          SBAR();
#pragma unroll
          for (int s = 0; s < 4; ++s) { S0 = MFMA32(kf[2 * s], qf[s], S0); S1 = MFMA32(kf[2 * s + 1], qf[s], S1); } }
        const LAS unsigned char* vb = lds + buf + vfo;
        s16x4 vlo[2][4], vhi[2][4];
#pragma unroll
        for (int d = 0; d < 4; ++d) { vlo[0][d] = vtr(vb + d * 4160); vhi[0][d] = vtr(vb + d * 4160 + 512); }
        SBAR();
        float mx = fmaxf(S0[0], S1[0]);
#pragma unroll
        for (int i = 1; i < 16; ++i) mx = fmaxf(mx, fmaxf(S0[i], S1[i]));
        mx = xmax32(mx);
        if (__any(mx > m + DIFF_THR)) {
            const float mn = fmaxf(m, mx), al = fexp2(m - mn);
            l *= al;
#pragma unroll
            for (int d = 0; d < 4; ++d) O[d] *= al;
            m = mn;
        }
        float ps = 0.f;
#pragma unroll
        for (int i = 0; i < 16; ++i) { S0[i] = fexp2(S0[i] - m); S1[i] = fexp2(S1[i] - m); ps += S0[i] + S1[i]; }
        l += ps;
        SBAR();
#pragma unroll
        for (int ks = 0; ks < 4; ++ks) {
            if (ks < 3) {
#pragma unroll
                for (int d = 0; d < 4; ++d) { vlo[(ks + 1) & 1][d] = vtr(vb + d * 4160 + (ks + 1) * 1024); vhi[(ks + 1) & 1][d] = vtr(vb + d * 4160 + (ks + 1) * 1024 + 512); }
            }
            const bf16x8 pf = (ks < 2) ? pack8(S0, ks & 1) : pack8(S1, ks & 1);
            SBAR();
#pragma unroll
            for (int d = 0; d < 4; ++d) O[d] = MFMA32(cat4(vlo[ks & 1][d], vhi[ks & 1][d]), pf, O[d]);
            SBAR();
        }
        if (t + 1 < NT) {
            const int nb = ((t + 1) & 1) * 33792;
#pragma unroll
            for (int i = 0; i < 2; ++i) { *(LAS u32x4*)(lds + nb + kdst[i]) = kr[i]; *(LAS u32x4*)(lds + nb + vdst[i]) = vr[i]; }
        }
        __syncthreads();
    }
    l = xsum32(l);
    LAS float* ex = (LAS float*)(lds + 69632) + qi * 4096 + lane;
    if (c == 1) {
        const float sc = lam / l;
#pragma unroll
        for (int d = 0; d < 4; ++d)
#pragma unroll
            for (int i = 0; i < 16; ++i) ex[(d * 16 + i) * 64] = O[d][i] * sc;
    }
    __syncthreads();
    if (c == 0) {
        const float inv = 1.0f / l; float ss = 0.f;
#pragma unroll
        for (int d = 0; d < 4; ++d)
#pragma unroll
            for (int i = 0; i < 16; ++i) { const float y = O[d][i] * inv - ex[(d * 16 + i) * 64]; O[d][i] = y; ss += y * y; }
        ss = xsum32(ss);
        const float rstd = 0.8f / sqrtf(ss * (1.0f / 128.0f) + EPS);
        const bf16_t* zrow = P + qrowi * NP + C_ZD + h * 128; bf16_t* orow = Acat + qrowi * KCAT + 512 + h * 128;
#pragma unroll
        for (int d = 0; d < 4; ++d)
#pragma unroll
            for (int gq = 0; gq < 4; ++gq) { const int dim = 32 * d + 8 * gq + 4 * hh;
                const f32x4 w = *(const f32x4*)(subln + dim); const u32x2 z = *(const u32x2*)(zrow + dim);
                const u32x2 o = {cvtpk(O[d][4 * gq] * rstd * w[0] * bflo(z.x), O[d][4 * gq + 1] * rstd * w[1] * bfhi(z.x)), cvtpk(O[d][4 * gq + 2] * rstd * w[2] * bflo(z.y), O[d][4 * gq + 3] * rstd * w[3] * bfhi(z.y))};
                *(u32x2*)(orow + dim) = o; }
    }
    __syncthreads();
}
#define XB_TMO      128
#define XB_XCNT(j)  (256  + 64 * (j))
#define XB_XSUB(j)  (1280 + 64 * (j))
#define XB_XGEN(j)  (2304 + 64 * (j))
#define XB_TOP      3328
#define XB_TOPGEN   3392
#define XCD_BAR_WORDS 3456
#define XB_SPIN_CAP (1u << 18)

__device__ __forceinline__ unsigned xb_ld(unsigned* p)              { return __hip_atomic_load(p, __ATOMIC_RELAXED, __HIP_MEMORY_SCOPE_AGENT); }
__device__ __forceinline__ unsigned xb_add(unsigned* p, unsigned v) { return __hip_atomic_fetch_add(p, v, __ATOMIC_RELAXED, __HIP_MEMORY_SCOPE_AGENT); }
__device__ __forceinline__ unsigned xb_xcc_id() { return (unsigned)__builtin_amdgcn_s_getreg((3 << 11) | 20) & 0xFu; }
#define XB_SPIN(cond, bar) do { unsigned _sp = 0; while (cond) { __builtin_amdgcn_s_sleep(1); \
    if ((++_sp & 255u) == 0u) { if (xb_ld(&(bar)[XB_TMO])) break; if (_sp > XB_SPIN_CAP) { atomicAdd(&(bar)[XB_TMO], 1u); break; } } } } while (0)

struct XcdBarrier {
    unsigned* bar; unsigned x;
    volatile LAS unsigned* st;
};

__device__ __forceinline__ XcdBarrier xcd_barrier_post(unsigned* bar, volatile LAS unsigned* st) {
    XcdBarrier b; b.bar = bar; b.x = xb_xcc_id(); b.st = st;
    if (threadIdx.x == 0) (void)xb_add(&bar[XB_XCNT(b.x)], 1u);
    return b;
}
__device__ __forceinline__ void xcd_barrier_complete(unsigned* bar, unsigned x, unsigned& nloc, unsigned& nx) {
    const unsigned G = gridDim.x * gridDim.y * gridDim.z;
    unsigned sum, cnt, mine, sp = 0u;
    for (;;) {
        sum = 0u; cnt = 0u; mine = 0u;
#pragma unroll
        for (unsigned j = 0; j < 16; ++j) { const unsigned c = xb_ld(&bar[XB_XCNT(j)]); sum += c; cnt += (c > 0u) ? 1u : 0u; mine = (j == x) ? c : mine; }
        if (sum == G) break;
        __builtin_amdgcn_s_sleep(1);
        if ((++sp & 255u) == 0u) { if (xb_ld(&bar[XB_TMO])) break; if (sp > XB_SPIN_CAP) { atomicAdd(&bar[XB_TMO], 1u); break; } }
    }
    nloc = mine > 0u ? mine : 1u; nx = cnt > 0u ? cnt : 1u;
}

__device__ __forceinline__ void xcd_barrier(const XcdBarrier& b) {
    asm volatile("s_waitcnt vmcnt(0)" ::: "memory");
    __syncthreads();
    if (threadIdx.x == 0) {
        unsigned* bar = b.bar;
        __builtin_amdgcn_s_waitcnt(0);
        unsigned nloc = b.st[0], nx = b.st[1];
        if (nloc == 0u) { xcd_barrier_complete(bar, b.x, nloc, nx); b.st[0] = nloc; b.st[1] = nx; }
        const unsigned old = xb_add(&bar[XB_XSUB(b.x)], 1u);
        const unsigned gen = old / nloc;
        if (old + 1u == (gen + 1u) * nloc) {
            __builtin_amdgcn_fence(__ATOMIC_RELEASE, "agent");
            asm volatile("s_waitcnt vmcnt(0)" ::: "memory");
            const unsigned og = xb_add(&bar[XB_TOP], 1u);
            const unsigned tg = og / nx;
            if (og + 1u == (tg + 1u) * nx) xb_add(&bar[XB_TOPGEN], 1u);
            else XB_SPIN(xb_ld(&bar[XB_TOPGEN]) == tg, bar);
            __builtin_amdgcn_fence(__ATOMIC_ACQUIRE, "agent");
            xb_add(&bar[XB_XGEN(b.x)], 1u);
            asm volatile("s_waitcnt vmcnt(0)" ::: "memory");
        } else {
            XB_SPIN(xb_ld(&bar[XB_XGEN(b.x)]) == gen, bar);
            __builtin_amdgcn_fence(__ATOMIC_ACQUIRE, "agent");
            asm volatile("s_waitcnt vmcnt(0)" ::: "memory");
        }
    }
    __syncthreads();
}

#ifndef REP_SYNC
#define REP_SYNC 1
#endif
__global__ void __launch_bounds__(NWAVES * 64, 2) hybrid_fwd(Args args) {
    extern __shared__ __attribute__((aligned(16))) unsigned char lds_raw[];
    LAS unsigned char* lds = (LAS unsigned char*)lds_raw;
    cg::grid_group grid = cg::this_grid();
    const int G = gridDim.x, bx = blockIdx.x;
    const int vcu = (G % 8 == 0) ? (bx % 8) * (G / 8) + bx / 8 : bx;
    unsigned char* ws = args.ws;
    unsigned* barw = (unsigned*)(ws + WS_BAR);
    XcdBarrier xbar; xbar.bar = barw; xbar.x = 0; xbar.st = (volatile LAS unsigned*)(lds + LDS_BYTES - 64);
    if (threadIdx.x < 16) ((volatile LAS unsigned*)(lds + LDS_BYTES - 64))[threadIdx.x] = 0u;
    if (bx == 0) { for (int i = threadIdx.x; i < XCD_BAR_WORDS; i += NWAVES * 64) barw[i] = 0u; }
    __syncthreads();
#define SEAM() do { for (int rs_ = 0; rs_ < REP_SYNC; ++rs_) xcd_barrier(xbar); } while (0)
    p0_prologue(args, lds, vcu, G);
    grid.sync();
    xbar = xcd_barrier_post(barw, (volatile LAS unsigned*)(lds + LDS_BYTES - 64));
    p1_h(args, vcu, G);
    p0b_weights(args, lds, vcu, G);
    SEAM();
    bf16_t* P = (bf16_t*)(ws + WS_PROJ); bf16_t* Acat = (bf16_t*)(ws + WS_ACAT); float* lse = (float*)(ws + WS_LSE);
#pragma unroll 1
    for (int ch = 0; ch < NCHUNK; ++ch) {
        if (ch > 0) p6_final(args, ch - 1, vcu, G);
        {
            typedef pg8::Gemm<MC, NIN, DM, DM, DM> GT; typedef pg8::StaticOrder<MC, NIN> SO;
            GT g{(const bf16_t*)(ws + WS_H) + (size_t)ch * MC * DM, (const bf16_t*)(ws + WS_WIN)};
            SO S; S.init(G, bx);
            pg8::EpiIn E{P, (bf16_t*)(ws + WS_KVD), (const int*)args.in[2] + (size_t)ch * MC};
            pg8::gemm_phase<pg8::EpiIn, SO, GT, true, true>(lds, g, S, E);
        }
        SEAM();
        {
            for (int u = vcu; u < BPC * 8 * 4; u += G) dsw_unit(lds, P, lse, Acat, u >> 5, (u >> 2) & 7, u & 3);
            const float lam = *(const float*)(ws + WS_LAM); const float* subln = (const float*)args.in[11];
            for (int u = vcu; u < BPC * 8 * 16; u += G) diff_unit(lds, P, (const bf16_t*)(ws + WS_KVD), Acat, subln, lam, u >> 7, (u >> 4) & 7, u & 15);
        }
        SEAM();
        {
            typedef pg8::Gemm<MC, DM, KCAT, KCAT, KCAT> GT; typedef pg8::StaticOrder<MC, DM> SO;
            GT g{Acat, (const bf16_t*)(ws + WS_WCAT)};
            SO S; S.init(G, bx);
            pg8::EpiU E{P};
            pg8::gemm_phase<pg8::EpiU, SO, GT, true, true>(lds, g, S, E);
        }
        SEAM();
        {
            typedef pg8::Gemm<MC, DM, DM, NP, DM> GT; typedef pg8::StaticOrder<MC, DM> SO;
            GT g{P + C_U, (const bf16_t*)(ws + WS_WOUT)};
            SO S; S.init(G, bx);
            pg8::EpiY E{Acat, (float*)(ws + WS_ROWSS) + (size_t)ch * MC};
            pg8::gemm_phase<pg8::EpiY, SO, GT, true, true>(lds, g, S, E);
        }
        SEAM();
    }
    p6_final(args, NCHUNK - 1, vcu, G);
#undef SEAM
}

extern "C" void kernel_launch(void* const* d_in, const int* in_sizes, int n_in, void* d_out, int out_size, void* d_ws, size_t ws_size, hipStream_t stream) {
    static int grid = 0;
    if (grid == 0) {
        if (n_in != 16 || out_size != MTOT * DM || ws_size < WS_END) { fprintf(stderr, "kernel_launch: unexpected shapes: n_in %d out %d ws %zu (need %zu)\n", n_in, out_size, ws_size, (size_t)WS_END); grid = -1; return; }
        int dev = 0, cus = 0, per_cu = 0;
        hipGetDevice(&dev); hipDeviceGetAttribute(&cus, hipDeviceAttributeMultiprocessorCount, dev);
        if (hipFuncSetAttribute((const void*)hybrid_fwd, hipFuncAttributeMaxDynamicSharedMemorySize, LDS_BYTES) != hipSuccess) { fprintf(stderr, "kernel_launch: hipFuncSetAttribute failed\n"); grid = -1; return; }
        hipOccupancyMaxActiveBlocksPerMultiprocessor(&per_cu, (const void*)hybrid_fwd, NWAVES * 64, LDS_BYTES);
        (void)hipGetLastError();
        if (per_cu < 1) { fprintf(stderr, "kernel_launch: occupancy query says %d blocks per CU\n", per_cu); per_cu = 1; }
        grid = cus;
        fprintf(stderr, "kernel_launch: cus %d per_cu %d grid %d ws %zu\n", cus, per_cu, grid, ws_size);
    }
    if (grid < 0) return;
    Args a{};
    for (int i = 0; i < 16; ++i) a.in[i] = d_in[i];
    a.out = (float*)d_out; a.ws = (unsigned char*)d_ws;
    a.ph_lo = 0; a.ph_hi = 0;
    void* kargs[] = {&a};
    hipError_t e = hipLaunchCooperativeKernel((const void*)hybrid_fwd, dim3(grid), dim3(NWAVES * 64), kargs, LDS_BYTES, stream);
    if (e != hipSuccess) fprintf(stderr, "kernel_launch: cooperative launch failed: %s (grid %d)\n", hipGetErrorString(e), grid);
}
```
